# Optimizing an MI355X kernel written in HIP

```python
import math
import jax
import jax.numpy as jnp
from jax import lax
import numpy as np

D_MODEL = 1024
BATCH = 32
SEQ = 2048
DEPTH = 2

GRID_W = 64
CTX_LEN = 256
EPS = 1e-6

ATT_HEAD_DIM = 64
ATT_Q_HEADS = (D_MODEL // 2) // ATT_HEAD_DIM
ATT_KV_HEADS = ATT_Q_HEADS // 2
ATT_GROUP = ATT_Q_HEADS // ATT_KV_HEADS
ATT_WIDTH = ATT_Q_HEADS * ATT_HEAD_DIM
ATT_KV_WIDTH = ATT_KV_HEADS * ATT_HEAD_DIM
ATT_IN = ATT_WIDTH + 2 * ATT_KV_WIDTH
Q_BLOCK = 128
ROPE_THETA = 10000.0

S5_WIDTH = D_MODEL // 4
S5_GROUP_CH = 16
S5_GROUPS = S5_WIDTH // S5_GROUP_CH
S5_STATE = 64

RWKV_WIDTH = D_MODEL // 4
RWKV_HEAD = 64
RWKV_HEADS = RWKV_WIDTH // RWKV_HEAD
DECAY_LORA = 64
AAA_LORA = 64
GATE_LORA = 128
RWKV_STREAM = 3 * RWKV_WIDTH + DECAY_LORA + AAA_LORA + GATE_LORA
SHORT_CONV = 3
GN_EPS = 64e-5

N_BRANCH = 3
OFF_S5 = ATT_IN
OFF_RWKV = OFF_S5 + S5_WIDTH
OFF_GATE = OFF_RWKV + RWKV_STREAM
IN_WIDTH = OFF_GATE + N_BRANCH * D_MODEL

N_EXPERT_GROUPS = 4
EXPERTS_PER_GROUP = 8
N_EXPERTS = N_EXPERT_GROUPS * EXPERTS_PER_GROUP
TOP_K = 2
D_EXPERT = D_MODEL // 2
MOE_BLOCK = 256

kernel_name = 'hybrid_attn_s5_rwkv7_hmoe_flow_block'


def rmsnorm(x, g):
    xf = x.astype(jnp.float32)
    y = xf * lax.rsqrt(jnp.mean(xf * xf, axis=-1, keepdims=True) + EPS)
    return (y * g.astype(jnp.float32)).astype(x.dtype)


def grid_positions(n_tokens):
    rows = n_tokens // GRID_W
    row = jnp.repeat(jnp.arange(rows, dtype=jnp.int32), GRID_W)
    col = jnp.tile(jnp.arange(GRID_W, dtype=jnp.int32), rows)
    return row, col


def rope_1d(x, pos):
    half = x.shape[-1] // 2
    inv = ROPE_THETA ** (-jnp.arange(half, dtype=jnp.float32) / half)
    ang = pos.astype(jnp.float32)[:, None] * inv[None, :]
    shape = (1, pos.shape[0]) + (1,) * (x.ndim - 3) + (half,)
    cos = jnp.cos(ang).reshape(shape).astype(x.dtype)
    sin = jnp.sin(ang).reshape(shape).astype(x.dtype)
    x1, x2 = x[..., :half], x[..., half:]
    return jnp.concatenate([x1 * cos - x2 * sin, x2 * cos + x1 * sin], axis=-1)


def axial_rope(x, row, col):
    h = x.shape[-1] // 2
    return jnp.concatenate([rope_1d(x[..., :h], row), rope_1d(x[..., h:], col)], axis=-1)


def attend(q, k, v):
    s = jnp.einsum('bqhgd,bkhd->bhgqk', q, k).astype(jnp.float32) * (ATT_HEAD_DIM ** -0.5)
    p = jax.nn.softmax(s, axis=-1).astype(v.dtype)
    return jnp.einsum('bhgqk,bkhd->bqhgd', p, v)


def attention_branch(a_lat, a_ctx, q_gain, k_gain, row, col, need_ctx):
    B, L, _ = a_lat.shape
    C = a_ctx.shape[1]

    def queries(a):
        q = a[..., :ATT_WIDTH].reshape(a.shape[:2] + (ATT_KV_HEADS, ATT_GROUP, ATT_HEAD_DIM))
        return rmsnorm(q, q_gain)

    def keys_values(a):
        k = a[..., ATT_WIDTH:ATT_WIDTH + ATT_KV_WIDTH].reshape(a.shape[:2] + (ATT_KV_HEADS, ATT_HEAD_DIM))
        v = a[..., ATT_WIDTH + ATT_KV_WIDTH:ATT_IN].reshape(a.shape[:2] + (ATT_KV_HEADS, ATT_HEAD_DIM))
        return rmsnorm(k, k_gain), v

    q_l = axial_rope(queries(a_lat), row, col)
    k_l, v_l = keys_values(a_lat)
    k_l = axial_rope(k_l, row, col)
    k_c, v_c = keys_values(a_ctx)
    k_all = jnp.concatenate([k_l, k_c], axis=1)
    v_all = jnp.concatenate([v_l, v_c], axis=1)
    n_blk = L // Q_BLOCK
    q_blocks = jnp.moveaxis(q_l.reshape((B, n_blk, Q_BLOCK) + q_l.shape[2:]), 1, 0)
    o = lax.map(lambda qb: attend(qb, k_all, v_all), q_blocks)
    o_lat = jnp.moveaxis(o, 0, 1).reshape(B, L, ATT_WIDTH)
    o_ctx = attend(queries(a_ctx), k_c, v_c).reshape(B, C, ATT_WIDTH) if need_ctx else None
    return o_lat, o_ctx


def s5_discretise(a_re, a_im, log_dt, b_re, b_im):
    dt = jnp.exp(log_dt.astype(jnp.float32))[:, None]
    lam_re = a_re.astype(jnp.float32)
    lam_im = a_im.astype(jnp.float32)
    mag = jnp.exp(lam_re * dt)
    ab_re = mag * jnp.cos(lam_im * dt)
    ab_im = mag * jnp.sin(lam_im * dt)
    den = lam_re * lam_re + lam_im * lam_im
    nr = ab_re - 1.0
    z_re = (nr * lam_re + ab_im * lam_im) / den
    z_im = (ab_im * lam_re - nr * lam_im) / den
    br = b_re.astype(jnp.float32)
    bi = b_im.astype(jnp.float32)
    bb_re = z_re[..., None] * br - z_im[..., None] * bi
    bb_im = z_re[..., None] * bi + z_im[..., None] * br
    return ab_re, ab_im, bb_re, bb_im


def complex_affine_combine(left, right):
    a1r, a1i, b1r, b1i = left
    a2r, a2i, b2r, b2i = right
    ar = a2r * a1r - a2i * a1i
    ai = a2r * a1i + a2i * a1r
    br = a2r * b1r - a2i * b1i + b2r
    bi = a2r * b1i + a2i * b1r + b2i
    return ar, ai, br, bi


def s5_scan(u, ab_re, ab_im, bb_re, bb_im, h0, reverse):
    bu_re = jnp.einsum('btgc,gnc->btgn', u, bb_re)
    bu_im = jnp.einsum('btgc,gnc->btgn', u, bb_im)
    a_re = jnp.broadcast_to(ab_re, bu_re.shape)
    a_im = jnp.broadcast_to(ab_im, bu_im.shape)
    acc_re, acc_im, h_re, h_im = lax.associative_scan(
        complex_affine_combine, (a_re, a_im, bu_re, bu_im), reverse=reverse, axis=1)
    if h0 is not None:
        h0_re, h0_im = h0[0][:, None], h0[1][:, None]
        h_re = h_re + acc_re * h0_re - acc_im * h0_im
        h_im = h_im + acc_re * h0_im + acc_im * h0_re
    return h_re, h_im


def s5_readout(h_re, h_im, c_re, c_im):
    return (jnp.einsum('btgn,gcn->btgc', h_re, c_re.astype(jnp.float32))
            - jnp.einsum('btgn,gcn->btgc', h_im, c_im.astype(jnp.float32)))


def s5_branch(s_lat, s_ctx, a_re, a_im, log_dt, b_re, b_im, c_re, c_im, d_skip, w_glu, need_ctx):
    def groups(s):
        return s.astype(jnp.float32).reshape(s.shape[:2] + (S5_GROUPS, S5_GROUP_CH))

    u_l, u_c = groups(s_lat), groups(s_ctx)
    ys_l, ys_c = [], []
    for d, rev in enumerate((False, True)):
        ab_re, ab_im, bb_re, bb_im = s5_discretise(a_re[d], a_im[d], log_dt[d], b_re[d], b_im[d])
        hc_re, hc_im = s5_scan(u_c, ab_re, ab_im, bb_re, bb_im, None, rev)
        edge = 0 if rev else -1
        hl_re, hl_im = s5_scan(u_l, ab_re, ab_im, bb_re, bb_im, (hc_re[:, edge], hc_im[:, edge]), rev)
        ys_l.append(s5_readout(hl_re, hl_im, c_re[d], c_im[d]))
        if need_ctx:
            ys_c.append(s5_readout(hc_re, hc_im, c_re[d], c_im[d]))

    def finish(ys, s):
        y = (ys[0] + ys[1]).reshape(s.shape) + d_skip.astype(jnp.float32) * s.astype(jnp.float32)
        z = jax.nn.gelu(y) @ w_glu.astype(jnp.float32)
        return (z[..., :S5_WIDTH] * jax.nn.sigmoid(z[..., S5_WIDTH:])).astype(s.dtype)

    return finish(ys_l, s_lat), (finish(ys_c, s_ctx) if need_ctx else None)


def short_conv(x, w):
    xp = jnp.pad(x, ((0, 0), (1, 1), (0, 0)))
    return xp[:, :-2] * w[0] + xp[:, 1:-1] * w[1] + xp[:, 2:] * w[2]


def rwkv_scan(r, decay, k, v, kk, kka, s0, reverse):
    def step(S, inp):
        r_t, w_t, k_t, v_t, kk_t, kka_t = inp
        sa = jnp.einsum('bhij,bhj->bhi', S, kk_t)
        S = S * w_t[:, :, None, :] - sa[..., None] * kka_t[:, :, None, :] + v_t[..., None] * k_t[:, :, None, :]
        y = None if r_t is None else jnp.einsum('bhij,bhj->bhi', S, r_t)
        return S, y

    def seq_first(t):
        return None if t is None else jnp.swapaxes(t, 0, 1)

    xs = tuple(seq_first(t) for t in (r, decay, k, v, kk, kka))
    s_fin, ys = lax.scan(step, s0, xs, reverse=reverse)
    return s_fin, seq_first(ys)


def rwkv_branch(z_lat, z_ctx, conv_w, w0, w2, a0, a2, g2, k_k, k_a, r_k, ln_w, ln_b, need_ctx):
    W = RWKV_WIDTH

    def heads(t):
        return t.reshape(t.shape[:-1] + (RWKV_HEADS, RWKV_HEAD))

    def streams(z):
        z = short_conv(z, conv_w).astype(jnp.float32)
        r, k, v = z[..., :W], z[..., W:2 * W], z[..., 2 * W:3 * W]
        o = 3 * W
        xw = jnp.tanh(z[..., o:o + DECAY_LORA])
        o += DECAY_LORA
        xa = z[..., o:o + AAA_LORA]
        o += AAA_LORA
        xg = z[..., o:]
        kk = heads(k * k_k.astype(jnp.float32))
        kk = kk * lax.rsqrt(jnp.sum(kk * kk, axis=-1, keepdims=True) + 1e-12)
        return r, k, v, xw, xa, xg, kk

    def direction_terms(k, xw, xa, d):
        wl = w0[d].astype(jnp.float32) + xw @ w2[d].astype(jnp.float32)
        decay = jnp.exp(-jnp.exp(-jax.nn.softplus(-wl) - 0.5))
        a = jax.nn.sigmoid(a0[d].astype(jnp.float32) + xa @ a2[d].astype(jnp.float32))
        kt = k * (1.0 + (a - 1.0) * k_a.astype(jnp.float32))
        return heads(decay), heads(a), heads(kt)

    r_l, k_l, v_l, xw_l, xa_l, xg_l, kk_l = streams(z_lat)
    r_c, k_c, v_c, xw_c, xa_c, xg_c, kk_c = streams(z_ctx)
    s0 = jnp.zeros((z_lat.shape[0], RWKV_HEADS, RWKV_HEAD, RWKV_HEAD), jnp.float32)
    ys_l, kts_l, ys_c, kts_c = [], [], [], []
    for d, rev in enumerate((False, True)):
        dec_c, a_c, kt_c = direction_terms(k_c, xw_c, xa_c, d)
        s_c, y_c = rwkv_scan(heads(r_c) if need_ctx else None, dec_c, kt_c, heads(v_c), kk_c, kk_c * a_c, s0, rev)
        dec_l, a_l, kt_l = direction_terms(k_l, xw_l, xa_l, d)
        _, y_l = rwkv_scan(heads(r_l), dec_l, kt_l, heads(v_l), kk_l, kk_l * a_l, s_c, rev)
        ys_l.append(y_l)
        kts_l.append(kt_l)
        if need_ctx:
            ys_c.append(y_c)
            kts_c.append(kt_c)

    def finish(ys, kts, r, v, xg, dtype):
        y = ys[0] + ys[1]
        mu = jnp.mean(y, axis=-1, keepdims=True)
        var = jnp.mean(jnp.square(y - mu), axis=-1, keepdims=True)
        y = (y - mu) * lax.rsqrt(var + GN_EPS) * heads(ln_w.astype(jnp.float32)) + heads(ln_b.astype(jnp.float32))
        bonus = jnp.sum(heads(r) * (kts[0] + kts[1]) * heads(r_k.astype(jnp.float32)), axis=-1, keepdims=True)
        y = y + bonus * heads(v)
        g = jax.nn.sigmoid(xg) @ g2.astype(jnp.float32)
        return (y.reshape(y.shape[:-2] + (W,)) * g).astype(dtype)

    o_lat = finish(ys_l, kts_l, r_l, v_l, xg_l, z_lat.dtype)
    o_ctx = finish(ys_c, kts_c, r_c, v_c, xg_c, z_ctx.dtype) if need_ctx else None
    return o_lat, o_ctx


def merge_branches(gate_logits, o_att, o_s5, o_rwkv, proj_att, proj_s5, proj_rwkv, w_out):
    g = jax.nn.sigmoid(gate_logits.astype(jnp.float32)).astype(o_att.dtype)
    g_att, g_s5, g_rw = jnp.split(g, N_BRANCH, axis=-1)
    merged = g_att * (o_att @ proj_att) + g_s5 * (o_s5 @ proj_s5) + g_rw * (o_rwkv @ proj_rwkv)
    return merged @ w_out


def moe_ffn(h, w_rg, b_rg, w_re, b_re, w_gate, w_up, w_down):
    T, D = h.shape
    hf = h.astype(jnp.float32)
    g_logits = hf @ w_rg.astype(jnp.float32) + b_rg.astype(jnp.float32)
    g_prob = jax.nn.softmax(g_logits, axis=-1)
    g_sel = jnp.argmax(g_logits, axis=-1).astype(jnp.int32)
    g_w = jnp.take_along_axis(g_prob, g_sel[:, None], axis=-1)
    e_logits = (hf @ w_re.astype(jnp.float32) + b_re.astype(jnp.float32)).reshape(T, N_EXPERT_GROUPS, EXPERTS_PER_GROUP)
    e_logits = jnp.take_along_axis(e_logits, g_sel[:, None, None], axis=1)[:, 0]
    e_prob = jax.nn.softmax(e_logits, axis=-1)
    top_p, top_i = lax.top_k(e_prob, TOP_K)
    gate = g_w * top_p / jnp.sum(top_p, axis=-1, keepdims=True)
    expert = g_sel[:, None] * EXPERTS_PER_GROUP + top_i.astype(jnp.int32)

    NK = T * TOP_K
    flat_e = expert.reshape(-1)
    flat_tok = jnp.repeat(jnp.arange(T, dtype=jnp.int32), TOP_K)
    flat_g = gate.reshape(-1)
    order = jnp.argsort(flat_e)
    se = flat_e[order]
    counts = jnp.bincount(flat_e, length=N_EXPERTS).astype(jnp.int32)
    padded = (counts + MOE_BLOCK - 1) // MOE_BLOCK * MOE_BLOCK
    pad_end = jnp.cumsum(padded)
    pad_start = pad_end - padded
    start = jnp.cumsum(counts) - counts
    dest = pad_start[se] + jnp.arange(NK, dtype=jnp.int32) - start[se]
    n_blocks = -(-NK // MOE_BLOCK) + N_EXPERTS
    P = n_blocks * MOE_BLOCK
    slot_tok = jnp.full((P,), T, jnp.int32).at[dest].set(flat_tok[order])
    slot_gate = jnp.zeros((P,), h.dtype).at[dest].set(flat_g[order].astype(h.dtype))
    blk_start = jnp.arange(n_blocks, dtype=jnp.int32) * MOE_BLOCK
    blk_expert = jnp.minimum(jnp.searchsorted(pad_end, blk_start, side='right'), N_EXPERTS - 1).astype(jnp.int32)
    h_pad = jnp.concatenate([h, jnp.zeros((1, D), h.dtype)], axis=0)

    def run_block(args):
        tok, e = args
        xb = h_pad[tok]
        return (jax.nn.silu(xb @ w_gate[e]) * (xb @ w_up[e])) @ w_down[e]

    out = lax.map(run_block, (slot_tok.reshape(n_blocks, MOE_BLOCK), blk_expert))
    y = jnp.zeros((T + 1, D), h.dtype).at[slot_tok].add(out.reshape(P, D) * slot_gate[:, None])
    return y[:T]


def setup_inputs(seed: int = 0) -> dict:
    key = jax.random.key(seed)
    keys = iter(jax.random.split(key, 64))
    f32 = jnp.float32

    def nrm(shape, scale):
        return jax.random.normal(next(keys), shape, f32) * scale

    def unif(shape, lo, hi):
        return jax.random.uniform(next(keys), shape, f32, lo, hi)

    D = D_MODEL
    G, N, CG, W = S5_GROUPS, S5_STATE, S5_GROUP_CH, RWKV_WIDTH
    E, F = N_EXPERTS, D_EXPERT
    return {
        'x': nrm((BATCH, SEQ, D), 1.0),
        'c': nrm((BATCH, D), 1.0),
        'ctx': nrm((BATCH, CTX_LEN, D), 1.0),
        'c_ctx': nrm((D,), 1.0),
        'w_mod': nrm((DEPTH, D, 6 * D), 0.5 * D ** -0.5),
        'b_mod': nrm((DEPTH, 6 * D), 0.02),
        'norm1': 1.0 + nrm((DEPTH, D), 0.05),
        'w_in': nrm((DEPTH, D, IN_WIDTH), D ** -0.5),
        'q_gain': 1.0 + nrm((DEPTH, ATT_HEAD_DIM), 0.05),
        'k_gain': 1.0 + nrm((DEPTH, ATT_HEAD_DIM), 0.05),
        's5_a_re': -0.5 + nrm((DEPTH, 2, G, N), 0.01),
        's5_a_im': math.pi * jnp.arange(N, dtype=f32) + nrm((DEPTH, 2, G, N), 0.01),
        's5_log_dt': unif((DEPTH, 2, G), math.log(1e-3), math.log(1e-1)),
        's5_b_re': nrm((DEPTH, 2, G, N, CG), (2 * CG) ** -0.5),
        's5_b_im': nrm((DEPTH, 2, G, N, CG), (2 * CG) ** -0.5),
        's5_c_re': nrm((DEPTH, 2, G, CG, N), (2 * N) ** -0.5),
        's5_c_im': nrm((DEPTH, 2, G, CG, N), (2 * N) ** -0.5),
        's5_d': nrm((DEPTH, S5_WIDTH), 1.0),
        's5_w_glu': nrm((DEPTH, S5_WIDTH, 2 * S5_WIDTH), S5_WIDTH ** -0.5),
        'rwkv_conv': jnp.array([0.25, 0.5, 0.25], f32)[None, :, None] + nrm((DEPTH, SHORT_CONV, RWKV_STREAM), 0.05),
        'rwkv_w0': unif((DEPTH, 2, W), -6.0, -1.0),
        'rwkv_w2': nrm((DEPTH, 2, DECAY_LORA, W), 0.1 * DECAY_LORA ** -0.5),
        'rwkv_a0': nrm((DEPTH, 2, W), 0.1),
        'rwkv_a2': nrm((DEPTH, 2, AAA_LORA, W), 0.1 * AAA_LORA ** -0.5),
        'rwkv_g2': nrm((DEPTH, GATE_LORA, W), GATE_LORA ** -0.5),
        'rwkv_k_k': 0.85 + nrm((DEPTH, W), 0.05),
        'rwkv_k_a': 1.0 + nrm((DEPTH, W), 0.05),
        'rwkv_r_k': nrm((DEPTH, W), 0.1),
        'rwkv_ln_w': 1.0 + nrm((DEPTH, W), 0.05),
        'rwkv_ln_b': nrm((DEPTH, W), 0.02),
        'proj_att': nrm((DEPTH, ATT_WIDTH, D), ATT_WIDTH ** -0.5),
        'proj_s5': nrm((DEPTH, S5_WIDTH, D), S5_WIDTH ** -0.5),
        'proj_rwkv': nrm((DEPTH, W, D), W ** -0.5),
        'w_out': nrm((DEPTH, D, D), D ** -0.5),
        'norm2': 1.0 + nrm((DEPTH, D), 0.05),
        'router_g_w': nrm((DEPTH, D, N_EXPERT_GROUPS), D ** -0.5),
        'router_g_b': nrm((DEPTH, N_EXPERT_GROUPS), 0.01),
        'router_e_w': nrm((DEPTH, D, E), D ** -0.5),
        'router_e_b': nrm((DEPTH, E), 0.01),
        'exp_w_gate': nrm((DEPTH, E, D, F), D ** -0.5),
        'exp_w_up': nrm((DEPTH, E, D, F), D ** -0.5),
        'exp_w_down': nrm((DEPTH, E, F, D), F ** -0.5),
    }


def reference(x, c, ctx, c_ctx, w_mod, b_mod, norm1, w_in, q_gain, k_gain,
              s5_a_re, s5_a_im, s5_log_dt, s5_b_re, s5_b_im, s5_c_re, s5_c_im, s5_d, s5_w_glu,
              rwkv_conv, rwkv_w0, rwkv_w2, rwkv_a0, rwkv_a2, rwkv_g2, rwkv_k_k, rwkv_k_a, rwkv_r_k,
              rwkv_ln_w, rwkv_ln_b, proj_att, proj_s5, proj_rwkv, w_out, norm2,
              router_g_w, router_g_b, router_e_w, router_e_b, exp_w_gate, exp_w_up, exp_w_down):
    B, L, D = x.shape
    C = ctx.shape[1]
    row, col = grid_positions(L)
    xl, xc = x, ctx
    for l in range(DEPTH):
        need_ctx = l < DEPTH - 1
        mod_lat = (jax.nn.silu(c) @ w_mod[l] + b_mod[l])[:, None, :]
        mod_ctx = jax.nn.silu(c_ctx) @ w_mod[l] + b_mod[l]
        sh1_l, sc1_l, g1_l, sh2_l, sc2_l, g2_l = jnp.split(mod_lat, 6, axis=-1)
        sh1_c, sc1_c, g1_c, sh2_c, sc2_c, g2_c = jnp.split(mod_ctx, 6, axis=-1)

        u_lat = (rmsnorm(xl, norm1[l]) * (1.0 + sc1_l) + sh1_l) @ w_in[l]
        u_ctx = (rmsnorm(xc, norm1[l]) * (1.0 + sc1_c) + sh1_c) @ w_in[l]
        o_att_l, o_att_c = attention_branch(u_lat[..., :OFF_S5], u_ctx[..., :OFF_S5],
                                            q_gain[l], k_gain[l], row, col, need_ctx)
        o_s5_l, o_s5_c = s5_branch(u_lat[..., OFF_S5:OFF_RWKV], u_ctx[..., OFF_S5:OFF_RWKV],
                                   s5_a_re[l], s5_a_im[l], s5_log_dt[l], s5_b_re[l], s5_b_im[l],
                                   s5_c_re[l], s5_c_im[l], s5_d[l], s5_w_glu[l], need_ctx)
        o_rw_l, o_rw_c = rwkv_branch(u_lat[..., OFF_RWKV:OFF_GATE], u_ctx[..., OFF_RWKV:OFF_GATE],
                                     rwkv_conv[l], rwkv_w0[l], rwkv_w2[l], rwkv_a0[l], rwkv_a2[l],
                                     rwkv_g2[l], rwkv_k_k[l], rwkv_k_a[l], rwkv_r_k[l],
                                     rwkv_ln_w[l], rwkv_ln_b[l], need_ctx)
        xl = xl + g1_l * merge_branches(u_lat[..., OFF_GATE:], o_att_l, o_s5_l, o_rw_l,
                                        proj_att[l], proj_s5[l], proj_rwkv[l], w_out[l])

        h2_l = rmsnorm(xl, norm2[l]) * (1.0 + sc2_l) + sh2_l
        if need_ctx:
            xc = xc + g1_c * merge_branches(u_ctx[..., OFF_GATE:], o_att_c, o_s5_c, o_rw_c,
                                            proj_att[l], proj_s5[l], proj_rwkv[l], w_out[l])
            h2_c = rmsnorm(xc, norm2[l]) * (1.0 + sc2_c) + sh2_c
            tokens = jnp.concatenate([h2_l.reshape(B * L, D), h2_c.reshape(B * C, D)], axis=0)
            y = moe_ffn(tokens, router_g_w[l], router_g_b[l], router_e_w[l], router_e_b[l],
                        exp_w_gate[l], exp_w_up[l], exp_w_down[l])
            xl = xl + g2_l * y[:B * L].reshape(B, L, D)
            xc = xc + g2_c * y[B * L:].reshape(B, C, D)
        else:
            y = moe_ffn(h2_l.reshape(B * L, D), router_g_w[l], router_g_b[l], router_e_w[l], router_e_b[l],
                        exp_w_gate[l], exp_w_up[l], exp_w_down[l])
            xl = xl + g2_l * y.reshape(B, L, D)
    return xl
```

```cpp
#include <hip/hip_runtime.h>
#include <cstdio>
#include <cstdint>
#define REP_PRE 1

#define LAS __attribute__((address_space(3)))
typedef unsigned short bf16_t;
typedef short bf16x8 __attribute__((ext_vector_type(8)));
typedef float f32x4 __attribute__((ext_vector_type(4)));
typedef float f32x2 __attribute__((ext_vector_type(2)));
typedef float f32x16 __attribute__((ext_vector_type(16)));
typedef unsigned u32x4 __attribute__((ext_vector_type(4)));
typedef unsigned u32x2 __attribute__((ext_vector_type(2)));

constexpr int NB = 32, SEQ = 2048, CTX = 256, D = 1024, DEPTH = 2;
constexpr int NLAT = NB * SEQ, NCTX = NB * CTX, NTOK = NLAT + NCTX;
constexpr int NKEY = SEQ + CTX;
constexpr int INW = 5376, NMIX = 2304;
constexpr int NEXP = 32, FEXP = 512;
constexpr int MODW = 6 * D;
constexpr int MAXBLK = 608;
constexpr float EPS = 1e-6f, GN_EPS = 64e-5f;
constexpr float LOG2E = 1.4426950408889634f;

constexpr size_t MiB = 1u << 20;
constexpr size_t WS_CTL = 0;
constexpr size_t CTL_BYTES = 1 * MiB;
constexpr size_t WS_MOD = 1 * MiB;
constexpr size_t WS_ROPE = 3 * MiB;
constexpr size_t WS_META = 4 * MiB;
constexpr size_t WS_XC = 8 * MiB;
constexpr size_t WS_W = 40 * MiB;
constexpr size_t WS_H = 74 * MiB;
constexpr size_t WS_BIG = 218 * MiB;
constexpr size_t WS_END = 1024 * MiB;
constexpr int CW_BAR = 0;
constexpr int CW_CNT = 4096;
constexpr int CW_CUR = 4096 + 64;
constexpr int CW_ATT = 4096 + 128;
constexpr int CW_DBG = 8192;
constexpr size_t MT_TOKE = 0;
constexpr size_t MT_TOKW = MT_TOKE + (size_t)NTOK * 2 * 4;
constexpr size_t MT_POS = MT_TOKW + (size_t)NTOK * 2 * 4;
constexpr size_t MT_SGATE = MT_POS + (size_t)NTOK * 2 * 4;
constexpr size_t MT_BLKE = MT_SGATE + (size_t)MAXBLK * 256 * 4;
constexpr size_t MT_WGCNT = MT_BLKE + 4096;
constexpr size_t MT_STOK = MT_WGCNT + 1024 * 32 * 4;
static_assert(MT_STOK + (size_t)MAXBLK * 256 * 4 <= 4 * MiB, "meta");
constexpr size_t SW_IN = 0;
constexpr size_t SW_GLU = SW_IN + (size_t)INW * D;
constexpr size_t SW_PA = SW_GLU + 512 * 256;
constexpr size_t SW_PS = SW_PA + 1024 * 512;
constexpr size_t SW_PR = SW_PS + 1024 * 256;
constexpr size_t SW_OUT = SW_PR + 1024 * 256;
constexpr size_t SW_LORA = SW_OUT + 1024 * 1024;
constexpr size_t SW_RT = SW_LORA + 1280 * 256;
constexpr size_t SW_LAYER = SW_RT + 256 * 1024;
static_assert(SW_LAYER * 2 * 2 <= 34 * MiB, "small weights");
constexpr size_t R36 = (size_t)NTOK * 256 * 2;
constexpr size_t BG_QKV = 0;
constexpr size_t BG_ORW = BG_QKV + 4 * R36;
constexpr size_t BG_OS5 = BG_ORW + R36;
constexpr size_t BG_US5 = BG_OS5 + R36;
constexpr size_t BG_URW = BG_US5 + R36;
constexpr size_t BG_STR = BG_URW + 5 * R36;
constexpr size_t BG_YS5 = BG_STR + 4 * R36;
constexpr size_t BG_YRW = BG_YS5 + 2 * R36;
constexpr size_t BG_VT = BG_YRW + 2 * R36;
constexpr size_t BG_MIX_END = BG_VT + R36;
constexpr size_t BG_GATES = BG_US5;
constexpr size_t BG_MERGED = BG_GATES + 12 * R36;
constexpr size_t BG_GATE_END = BG_MERGED + 4 * R36;
constexpr size_t BG_WGU = 0;
constexpr size_t BG_WDN = 64 * MiB;
constexpr size_t BG_LOGIT = 96 * MiB;
constexpr size_t BG_XS = 114 * MiB;
constexpr size_t BG_ACT = BG_XS + (size_t)MAXBLK * 256 * 1024 * 2;
constexpr size_t BG_MOE_END = BG_ACT + (size_t)MAXBLK * 256 * 512 * 2;
static_assert(WS_BIG + BG_MIX_END <= WS_END && WS_BIG + BG_GATE_END <= WS_END && WS_BIG + BG_MOE_END <= WS_END, "workspace");
static_assert(BG_YS5 >= BG_GATES + 0 && BG_MERGED >= BG_YS5, "layout sanity");

constexpr int LDS_BYTES = 147456;
constexpr int LDS_BARW = LDS_BYTES - 16;

struct Args { const float* in[42]; float* out; unsigned char* ws; };
#ifndef PH_MASK
#define PH_MASK 0xFFFFFFFFu
#endif
#define PH_ON(n) (((PH_MASK) >> (n)) & 1u)
#ifndef REPMASK
#define REPMASK 0u
#endif
#ifndef STOP_L1
#define STOP_L1 99
#endif
constexpr int LDS_PTR = LDS_BYTES - 512;
__device__ __forceinline__ const float* ldptr(LAS unsigned char* lds, int i) {
    const unsigned long long v = *(volatile LAS unsigned long long*)(lds + LDS_PTR + i * 8);
    const unsigned lo = __builtin_amdgcn_readfirstlane((unsigned)v), hi = __builtin_amdgcn_readfirstlane((unsigned)(v >> 32));
    typedef __attribute__((address_space(1))) const float gfloat_t;
    return (const float*)(gfloat_t*)(((unsigned long long)hi << 32) | lo);
}
#define INP(i) ldptr(lds, (i))
#define OUTP() ((float*)ldptr(lds, 42))
#define WSB() ((unsigned char*)ldptr(lds, 43))

typedef __bf16 bf16v2_t __attribute__((ext_vector_type(2)));
__device__ __forceinline__ unsigned cvt_pk_bf16(float lo, float hi) { const f32x2 v = (f32x2){lo, hi}; const bf16v2_t b = __builtin_convertvector(v, bf16v2_t); return __builtin_bit_cast(unsigned, b); }
__device__ __forceinline__ float bflo(unsigned u) { return __uint_as_float(u << 16); }
__device__ __forceinline__ float bfhi(unsigned u) { return __uint_as_float(u & 0xffff0000u); }
__device__ __forceinline__ float bf2f(bf16_t v) { return __uint_as_float((unsigned)v << 16); }
__device__ __forceinline__ bf16_t f2bf(float f) { return (bf16_t)(cvt_pk_bf16(f, 0.f) & 0xffffu); }
__device__ __forceinline__ void unpack8(const u32x4 w, float (&x)[8]) { x[0] = bflo(w[0]); x[1] = bfhi(w[0]); x[2] = bflo(w[1]); x[3] = bfhi(w[1]); x[4] = bflo(w[2]); x[5] = bfhi(w[2]); x[6] = bflo(w[3]); x[7] = bfhi(w[3]); }
__device__ __forceinline__ u32x4 pack8f(const float (&x)[8]) { return (u32x4){cvt_pk_bf16(x[0], x[1]), cvt_pk_bf16(x[2], x[3]), cvt_pk_bf16(x[4], x[5]), cvt_pk_bf16(x[6], x[7])}; }
__device__ __forceinline__ float sigmoidf_(float x) { return __builtin_amdgcn_rcpf(1.0f + __builtin_amdgcn_exp2f(-1.4426950408889634f * x)); }
template <int CTRL> __device__ __forceinline__ float dpp(float x) { return __builtin_bit_cast(float, __builtin_amdgcn_mov_dpp(__builtin_bit_cast(int, x), CTRL, 0xf, 0xf, true)); }
__device__ __forceinline__ float sum8(float x) { x += dpp<0xB1>(x); x += dpp<0x4E>(x); x += dpp<0x141>(x); return x; }
__device__ __forceinline__ float wave_sum(float x) {
    x += dpp<0xB1>(x); x += dpp<0x4E>(x); x += dpp<0x141>(x);
    x += dpp<0x140>(x);
    x += __shfl_xor(x, 16); x += __shfl_xor(x, 32); return x;
}
__device__ __forceinline__ float swap32_max(float x) { auto rr = __builtin_amdgcn_permlane32_swap(__float_as_uint(x), __float_as_uint(x), false, false); return fmaxf(__uint_as_float(rr[0]), __uint_as_float(rr[1])); }
__device__ __forceinline__ float swap32_sum(float x) { auto rr = __builtin_amdgcn_permlane32_swap(__float_as_uint(x), __float_as_uint(x), false, false); return __uint_as_float(rr[0]) + __uint_as_float(rr[1]); }
__device__ __forceinline__ int opaque_tid() { int t = threadIdx.x; asm volatile("" : "+v"(t)); return t; }
__device__ __forceinline__ int tok_modrow(int row) { return row < NLAT ? (row >> 11) : 32; }
__device__ __forceinline__ int seq_row(int b, int d, int s) {
    if (s < CTX) { const int ci = d ? (CTX - 1 - s) : s; return NLAT + b * CTX + ci; }
    const int li0 = s - CTX, li = d ? (SEQ - 1 - li0) : li0; return b * SEQ + li;
}
__device__ __forceinline__ int seq_base(int b, int d, int s0) {
    if (s0 < CTX) return NLAT + b * CTX + (d ? (CTX - 1 - s0) : s0);
    const int li0 = s0 - CTX; return b * SEQ + (d ? (SEQ - 1 - li0) : li0);
}
__device__ __forceinline__ void sincos_d(double x, double& s, double& c) {
    const double k = rint(x * 0.6366197723675814);
    double r = fma(-k, 1.5707963267948966, x); r = fma(-k, 6.123233995736766e-17, r);
    const double r2 = r * r;
    double sp = 1.58969099521155010221e-10; sp = fma(sp, r2, -2.50507602534068634195e-08); sp = fma(sp, r2, 2.75573137070700676789e-06); sp = fma(sp, r2, -1.98412698298579493134e-04);
    sp = fma(sp, r2, 8.33333333332248946124e-03); sp = fma(sp, r2, -1.66666666666666324348e-01); const double sr = fma(sp * r2, r, r);
    double cp = -1.13596475577881948265e-11; cp = fma(cp, r2, 2.08757232129817482790e-09); cp = fma(cp, r2, -2.75573143513906633035e-07); cp = fma(cp, r2, 2.48015872894767294178e-05);
    cp = fma(cp, r2, -1.38888888888741095749e-03); cp = fma(cp, r2, 4.16666666666666019037e-02); const double cr = fma(fma(cp, r2, -0.5), r2, 1.0);
    const int q = ((int)k) & 3;
    s = (q == 0) ? sr : (q == 1) ? cr : (q == 2) ? -sr : -cr;
    c = (q == 0) ? cr : (q == 1) ? -sr : (q == 2) ? -cr : sr;
}

#define XB_TMO      128
#define XB_XCNT(j)  (256  + 64 * (j))
#define XB_XSUB(j)  (1280 + 64 * (j))
#define XB_XGEN(j)  (2304 + 64 * (j))
#define XB_TOP      3328
#define XB_TOPGEN   3392
#define XCD_BAR_WORDS 3456
#define XB_SPIN_CAP (1u << 26)
__device__ __forceinline__ unsigned xb_ld(unsigned* p)              { return __hip_atomic_load(p, __ATOMIC_RELAXED, __HIP_MEMORY_SCOPE_AGENT); }
__device__ __forceinline__ unsigned xb_add(unsigned* p, unsigned v) { return __hip_atomic_fetch_add(p, v, __ATOMIC_RELAXED, __HIP_MEMORY_SCOPE_AGENT); }
__device__ __forceinline__ unsigned xb_xcc_id() { return (unsigned)__builtin_amdgcn_s_getreg((3 << 11) | 20) & 0xFu; }
#define XB_SPIN(cond, bar) do { unsigned _sp = 0; while (cond) { __builtin_amdgcn_s_sleep(1); \
    if ((++_sp & 255u) == 0u) { if (xb_ld(&(bar)[XB_TMO])) break; if (_sp > XB_SPIN_CAP) { atomicAdd(&(bar)[XB_TMO], 1u); break; } } } } while (0)
struct XcdBarrier { unsigned* bar; unsigned x; volatile LAS unsigned* st; };
__device__ __forceinline__ XcdBarrier xcd_barrier_post(unsigned* bar, volatile LAS unsigned* st) {
    XcdBarrier b; b.bar = bar; b.x = xb_xcc_id(); b.st = st;
    if (threadIdx.x == 0) (void)xb_add(&bar[XB_XCNT(b.x)], 1u);
    return b;
}
__device__ __forceinline__ void xcd_barrier_complete(unsigned* bar, unsigned x, unsigned& nloc, unsigned& nx) {
    const unsigned G = gridDim.x * gridDim.y * gridDim.z;
    unsigned sum, cnt, mine, sp = 0u;
    for (;;) {
        sum = 0u; cnt = 0u; mine = 0u;
#pragma unroll
        for (unsigned j = 0; j < 16; ++j) { const unsigned c = xb_ld(&bar[XB_XCNT(j)]); sum += c; cnt += (c > 0u) ? 1u : 0u; mine = (j == x) ? c : mine; }
        if (sum == G) break;
        __builtin_amdgcn_s_sleep(1);
        if ((++sp & 255u) == 0u) { if (xb_ld(&bar[XB_TMO])) break; if (sp > XB_SPIN_CAP) { atomicAdd(&bar[XB_TMO], 1u); break; } }
    }
    nloc = mine > 0u ? mine : 1u; nx = cnt > 0u ? cnt : 1u;
}
#ifndef REP_BAR
#define REP_BAR 1
#endif
__device__ __forceinline__ void xcd_barrier1(const XcdBarrier& b);
__device__ __forceinline__ void xcd_barrier(const XcdBarrier& b) { for (int r = 0; r < REP_BAR; ++r) xcd_barrier1(b); }
__device__ __forceinline__ void xcd_barrier1(const XcdBarrier& b) {
#ifdef XB_STRONG
    __builtin_amdgcn_fence(__ATOMIC_SEQ_CST, "");
#endif
    asm volatile("s_waitcnt vmcnt(0)" ::: "memory");
    __syncthreads();
    if (threadIdx.x == 0) {
        unsigned* bar = b.bar;
        __builtin_amdgcn_s_waitcnt(0);
        unsigned nloc = b.st[0], nx = b.st[1];
        if (nloc == 0u) { xcd_barrier_complete(bar, b.x, nloc, nx); b.st[0] = nloc; b.st[1] = nx; }
        const unsigned old = xb_add(&bar[XB_XSUB(b.x)], 1u);
        const unsigned gen = old / nloc;
        if (old + 1u == (gen + 1u) * nloc) {
            __builtin_amdgcn_fence(__ATOMIC_RELEASE, "agent");
            asm volatile("s_waitcnt vmcnt(0)" ::: "memory");
            const unsigned og = xb_add(&bar[XB_TOP], 1u);
            const unsigned tg = og / nx;
            if (og + 1u == (tg + 1u) * nx) xb_add(&bar[XB_TOPGEN], 1u);
            else XB_SPIN(xb_ld(&bar[XB_TOPGEN]) == tg, bar);
            __builtin_amdgcn_fence(__ATOMIC_ACQUIRE, "agent");
            xb_add(&bar[XB_XGEN(b.x)], 1u);
            asm volatile("s_waitcnt vmcnt(0)" ::: "memory");
        } else {
            XB_SPIN(xb_ld(&bar[XB_XGEN(b.x)]) == gen, bar);
            __builtin_amdgcn_fence(__ATOMIC_ACQUIRE, "agent");
            asm volatile("s_waitcnt vmcnt(0)" ::: "memory");
        }
    }
    __syncthreads();
#ifdef XB_STRONG
    __builtin_amdgcn_fence(__ATOMIC_SEQ_CST, ""); asm volatile("s_waitcnt vmcnt(0)" ::: "memory"); __syncthreads();
#endif
}

__device__ __forceinline__ void cu_l1_invalidate() {
    asm volatile("s_waitcnt vmcnt(0)" ::: "memory"); __syncthreads();
    if (threadIdx.x == 0) { __builtin_amdgcn_fence(__ATOMIC_ACQUIRE, "agent"); asm volatile("s_waitcnt vmcnt(0)" ::: "memory"); }
    __syncthreads();
}
namespace pg8 {
constexpr int BM = 256, BK = 64, HALF = 128, HTB = HALF * BK * 2, STAGE_BYTES = 8 * HTB, NXCD = 8, WGM = 8;
__host__ __device__ __forceinline__ int lds_byte(int r, int c) { const int st = (r >> 4) * 2 + (c >> 5), rr = r & 15, cc = c & 31, ob = rr * 64 + cc * 2; return st * 1024 + (ob ^ (((ob >> 9) & 1) << 5)); }
__host__ __device__ __forceinline__ void stage_rc(int b, int& R, int& C) { const int st = b / 1024, sb = b % 1024, swz = sb ^ (((sb >> 9) & 1) << 5); R = (st >> 1) * 16 + swz / 64; C = (st & 1) * 32 + (swz % 64) / 2; }
__host__ __device__ __forceinline__ int perm32(int rho) { const int n = rho >> 4, i = rho & 15; return 8 * (i >> 2) + 4 * n + (i & 3); }
struct Unit { int pm, pn; };
struct Gemm { const bf16_t* A; const bf16_t* Bt; int M, N, K, lda; };
struct StaticOrder {
    int nM, nN, nwg, G, c;
    __device__ void init(int M, int N, int G_, int c_) { nM = M / BM; nN = N / BM; nwg = nM * nN; G = G_; c = c_; }
    __device__ bool next(int i, Unit& u) const {
        const long L = (long)i * G + c; if (L >= nwg) return false;
        int wgid = (int)L; { const int q = nwg / NXCD, r = nwg % NXCD, xcd = wgid % NXCD, off = wgid / NXCD; wgid = (xcd < r ? xcd * (q + 1) : r * (q + 1) + (xcd - r) * q) + off; }
        const int nig = WGM * nN, gid = wgid / nig, fm = gid * WGM, gsz = (nM - fm) < WGM ? (nM - fm) : WGM;
        u.pm = fm + ((wgid % nig) % gsz); u.pn = (wgid % nig) / gsz; return true;
    }
};
struct MoeOrder {
    int nunits, G, c; const int* blk_e;
    __device__ bool next(int i, Unit& u) const {
        if ((G & 7) == 0) { const int xcd = c & 7, s = i * (G >> 3) + (c >> 3), rb = (s >> 2) * 8 + xcd; if (rb >= (nunits >> 2)) return false; u.pm = rb; u.pn = blk_e[rb] * 4 + (s & 3); return true; }
        const int L = i * G + c; if (L >= nunits) return false; const int rb = L >> 2; u.pm = rb; u.pn = blk_e[rb] * 4 + (L & 3); return true; }
};

template <class Epi, class Sched>
__device__ __forceinline__ void gemm_phase(LAS unsigned char* lds, const Gemm g, const Sched& S, const Epi& E) {
    const int tid = opaque_tid(), wid = __builtin_amdgcn_readfirstlane(tid >> 6), lane = tid & 63, wr = wid >> 2, wc = wid & 3, fr = lane & 15, fq = lane >> 4;
    const int K = g.K, nt = K / BK, lda = g.lda;
    unsigned voffA[2], voffB[2];
#pragma unroll
    for (int i = 0; i < 2; ++i) { int R, C; stage_rc(tid * 16 + i * 8192, R, C); const int Rb = Epi::PERM ? ((R & ~31) + perm32(R & 31)) : R;
        voffA[i] = (unsigned)(R * lda + C) * 2u; voffB[i] = (unsigned)(Rb * K + C) * 2u; }
    const size_t kstep = (size_t)(BK * 2);
    const size_t hstepA = (size_t)HALF * lda * 2, hstepB = (size_t)HALF * K * 2;
    const size_t tstepA = 2 * hstepA, tstepB = 2 * hstepB;
    const unsigned ldsw = (unsigned)wid * 1024u;
    const int aoff = lds_byte(wr * 64 + fr, fq * 8), boff = lds_byte(wc * 32 + fr, fq * 8);
#define PG8_SA(b, h) (((b) * 2 + (h)) * HTB)
#define PG8_SB(b, h) ((4 + (b) * 2 + (h)) * HTB)
#define PG8_STAGE(bufoff, gbase, voff) do { _Pragma("unroll") for (int _i = 0; _i < 2; ++_i) \
        __builtin_amdgcn_global_load_lds((const unsigned*)((const char*)(gbase) + (voff)[_i]), (LAS unsigned*)(lds + (bufoff) + ldsw + _i * 8192), 16, 0, 0); } while (0)
#define PG8_LDA(dst, b, h) do { _Pragma("unroll") for (int m = 0; m < 4; ++m) _Pragma("unroll") for (int k = 0; k < 2; ++k) dst[m][k] = *(const LAS bf16x8*)(lds + PG8_SA(b, h) + aoff + m * 2048 + k * 1024); } while (0)
#define PG8_LDB(dst, b, h) do { _Pragma("unroll") for (int n = 0; n < 2; ++n) _Pragma("unroll") for (int k = 0; k < 2; ++k) dst[n][k] = *(const LAS bf16x8*)(lds + PG8_SB(b, h) + boff + n * 2048 + k * 1024); } while (0)
#define PG8_MMA(ai, bj, At, Bt) do { __builtin_amdgcn_s_setprio(1); _Pragma("unroll") for (int m = 0; m < 4; ++m) _Pragma("unroll") for (int n = 0; n < 2; ++n) _Pragma("unroll") for (int k = 0; k < 2; ++k) \
        acc[ai][bj][m][n] = __builtin_amdgcn_mfma_f32_16x16x32_bf16(Bt[n][k], At[m][k], acc[ai][bj][m][n], 0, 0, 0); __builtin_amdgcn_s_setprio(0); } while (0)
#define PG8_WAIT_V(n) asm volatile("s_waitcnt vmcnt(" #n ")" ::: "memory")
#define PG8_WAIT_L(n) asm volatile("s_waitcnt lgkmcnt(" #n ")" ::: "memory")
#define PG8_BAR __builtin_amdgcn_s_barrier()
#define PG8_SCHED __builtin_amdgcn_sched_barrier(0)
    Unit cur, nxt; int ui = 0;
    if (!S.next(0, cur)) return;
    f32x4 acc[2][2][4][2];
#pragma unroll
    for (int a = 0; a < 2; ++a)
#pragma unroll
        for (int b = 0; b < 2; ++b)
#pragma unroll
            for (int m = 0; m < 4; ++m)
#pragma unroll
                for (int n = 0; n < 2; ++n) acc[a][b][m][n] = (f32x4){0.f, 0.f, 0.f, 0.f};
    bf16x8 At[4][2], B0[2][2], B1[2][2];
    const char* cA = (const char*)g.A + (size_t)cur.pm * tstepA; const char* cB = (const char*)g.Bt + (size_t)cur.pn * tstepB;
    PG8_STAGE(PG8_SB(0, 0), cB, voffB); PG8_STAGE(PG8_SA(0, 0), cA, voffA); PG8_STAGE(PG8_SB(0, 1), cB + hstepB, voffB); PG8_STAGE(PG8_SA(0, 1), cA + hstepA, voffA);
    if (wr == 1) PG8_BAR;
    PG8_WAIT_V(4); PG8_BAR;
    PG8_STAGE(PG8_SB(1, 0), cB + kstep, voffB); PG8_STAGE(PG8_SA(1, 0), cA + kstep, voffA); PG8_STAGE(PG8_SB(1, 1), cB + hstepB + kstep, voffB);
    PG8_WAIT_V(6); PG8_BAR;
    for (;;) {
        const bool has_next = S.next(ui + 1, nxt);
        const char* nA = has_next ? (const char*)g.A + (size_t)nxt.pm * tstepA : cA; const char* nB = has_next ? (const char*)g.Bt + (size_t)nxt.pn * tstepB : cB;
        for (int t = 0; t < nt; t += 2) {
            const bool last = (t == nt - 2);
            const char* a1 = cA + (size_t)(t + 1) * kstep;
            const char* a2 = last ? nA : cA + (size_t)(t + 2) * kstep; const char* b2 = last ? nB : cB + (size_t)(t + 2) * kstep;
            const char* a3 = a2 + kstep; const char* b3 = b2 + kstep;
            PG8_LDB(B0, 0, 0); PG8_SCHED; PG8_LDA(At, 0, 0); PG8_STAGE(PG8_SA(1, 1), a1 + hstepA, voffA);
            PG8_WAIT_L(8); PG8_BAR; PG8_WAIT_L(0); PG8_MMA(0, 0, At, B0); PG8_BAR; PG8_SCHED;
            PG8_LDB(B1, 0, 1); PG8_STAGE(PG8_SB(0, 0), b2, voffB);
            PG8_BAR; PG8_WAIT_L(0); PG8_MMA(0, 1, At, B1); PG8_BAR;
            PG8_LDA(At, 0, 1); PG8_STAGE(PG8_SA(0, 0), a2, voffA);
            PG8_BAR; PG8_WAIT_L(0); PG8_MMA(1, 0, At, B0); PG8_BAR; PG8_SCHED;
            PG8_STAGE(PG8_SB(0, 1), b2 + hstepB, voffB);
            PG8_WAIT_V(6); PG8_BAR; PG8_MMA(1, 1, At, B1); PG8_BAR;
            PG8_LDB(B0, 1, 0); PG8_SCHED; PG8_LDA(At, 1, 0); PG8_STAGE(PG8_SA(0, 1), a2 + hstepA, voffA);
            PG8_WAIT_L(8); PG8_BAR; PG8_WAIT_L(0); PG8_MMA(0, 0, At, B0); PG8_BAR; PG8_SCHED;
            PG8_LDB(B1, 1, 1); PG8_STAGE(PG8_SB(1, 0), b3, voffB);
            PG8_BAR; PG8_WAIT_L(0); PG8_MMA(0, 1, At, B1); PG8_BAR;
            PG8_LDA(At, 1, 1); PG8_STAGE(PG8_SA(1, 0), a3, voffA);
            PG8_BAR; PG8_WAIT_L(0); PG8_MMA(1, 0, At, B0); PG8_BAR; PG8_SCHED;
            PG8_STAGE(PG8_SB(1, 1), b3 + hstepB, voffB);
            PG8_WAIT_V(6); PG8_BAR; PG8_MMA(1, 1, At, B1); PG8_BAR;
        }
        { int fr2 = fr, fq2 = fq; asm volatile("" : "+v"(fr2), "+v"(fq2)); E(acc, cur, wr, wc, fr2, fq2); }
        if (!has_next) break;
#pragma unroll
        for (int a = 0; a < 2; ++a)
#pragma unroll
            for (int b = 0; b < 2; ++b)
#pragma unroll
                for (int m = 0; m < 4; ++m)
#pragma unroll
                    for (int n = 0; n < 2; ++n) acc[a][b][m][n] = (f32x4){0.f, 0.f, 0.f, 0.f};
        cur = nxt; cA = nA; cB = nB; ++ui;
    }
    PG8_WAIT_V(0);
    if (wr == 0) PG8_BAR;
    PG8_BAR;
#undef PG8_SA
#undef PG8_SB
#undef PG8_STAGE
#undef PG8_LDA
#undef PG8_LDB
#undef PG8_MMA
#undef PG8_WAIT_V
#undef PG8_WAIT_L
#undef PG8_BAR
#undef PG8_SCHED
}

template <class Epi, class Sched>
__device__ __forceinline__ void gemm_phase_gather(LAS unsigned char* lds, const Gemm g, const int* stok, const Sched& S, const Epi& E) {
    const int tid = opaque_tid(), wid = __builtin_amdgcn_readfirstlane(tid >> 6), lane = tid & 63, wr = wid >> 2, wc = wid & 3, fr = lane & 15, fq = lane >> 4;
    const int K = g.K, nt = K / BK, lda = g.lda;
    unsigned voffA[2], voffB[2]; int rowA[2];
#pragma unroll
    for (int i = 0; i < 2; ++i) { int R, C; stage_rc(tid * 16 + i * 8192, R, C); const int Rb = Epi::PERM ? ((R & ~31) + perm32(R & 31)) : R;
        voffA[i] = (unsigned)C * 2u; rowA[i] = R; voffB[i] = (unsigned)(Rb * K + C) * 2u; }
    const size_t kstep = (size_t)(BK * 2);
    const size_t hstepA = (size_t)HALF * lda * 2, hstepB = (size_t)HALF * K * 2;
    const size_t tstepA = 2 * hstepA, tstepB = 2 * hstepB;
    const unsigned ldsw = (unsigned)wid * 1024u;
    const int aoff = lds_byte(wr * 64 + fr, fq * 8), boff = lds_byte(wc * 32 + fr, fq * 8);
#define PG8_SA(b, h) (((b) * 2 + (h)) * HTB)
#define PG8_SB(b, h) ((4 + (b) * 2 + (h)) * HTB)
#define PG8_STAGE(bufoff, gbase, voff) do { _Pragma("unroll") for (int _i = 0; _i < 2; ++_i) \
        __builtin_amdgcn_global_load_lds((const unsigned*)((const char*)(gbase) + (voff)[_i]), (LAS unsigned*)(lds + (bufoff) + ldsw + _i * 8192), 16, 0, 0); } while (0)
#define PG8_LDA(dst, b, h) do { _Pragma("unroll") for (int m = 0; m < 4; ++m) _Pragma("unroll") for (int k = 0; k < 2; ++k) dst[m][k] = *(const LAS bf16x8*)(lds + PG8_SA(b, h) + aoff + m * 2048 + k * 1024); } while (0)
#define PG8_LDB(dst, b, h) do { _Pragma("unroll") for (int n = 0; n < 2; ++n) _Pragma("unroll") for (int k = 0; k < 2; ++k) dst[n][k] = *(const LAS bf16x8*)(lds + PG8_SB(b, h) + boff + n * 2048 + k * 1024); } while (0)
#define PG8_MMA(ai, bj, At, Bt) do { __builtin_amdgcn_s_setprio(1); _Pragma("unroll") for (int m = 0; m < 4; ++m) _Pragma("unroll") for (int n = 0; n < 2; ++n) _Pragma("unroll") for (int k = 0; k < 2; ++k) \
        acc[ai][bj][m][n] = __builtin_amdgcn_mfma_f32_16x16x32_bf16(Bt[n][k], At[m][k], acc[ai][bj][m][n], 0, 0, 0); __builtin_amdgcn_s_setprio(0); } while (0)
#define PG8_WAIT_V(n) asm volatile("s_waitcnt vmcnt(" #n ")" ::: "memory")
#define PG8_WAIT_L(n) asm volatile("s_waitcnt lgkmcnt(" #n ")" ::: "memory")
#define PG8_BAR __builtin_amdgcn_s_barrier()
#define PG8_SCHED __builtin_amdgcn_sched_barrier(0)
    Unit cur, nxt; int ui = 0;
    if (!S.next(0, cur)) return;
    f32x4 acc[2][2][4][2];
#pragma unroll
    for (int a = 0; a < 2; ++a)
#pragma unroll
        for (int b = 0; b < 2; ++b)
#pragma unroll
            for (int m = 0; m < 4; ++m)
#pragma unroll
                for (int n = 0; n < 2; ++n) acc[a][b][m][n] = (f32x4){0.f, 0.f, 0.f, 0.f};
    bf16x8 At[4][2], B0[2][2], B1[2][2];
    const char* cA = (const char*)g.A; const char* cB = (const char*)g.Bt + (size_t)cur.pn * tstepB;
    unsigned ro[2][2], rn[2][2];
#define PGG_ROWS(dst, pm_) do { _Pragma("unroll") for (int hh = 0; hh < 2; ++hh) _Pragma("unroll") for (int ii = 0; ii < 2; ++ii) dst[hh][ii] = (unsigned)stok[(pm_) * 256 + hh * 128 + rowA[ii]] * (unsigned)(lda * 2) + voffA[ii]; } while (0)
    PGG_ROWS(ro, cur.pm);
    PG8_STAGE(PG8_SB(0, 0), cB, voffB); PG8_STAGE(PG8_SA(0, 0), cA, ro[0]); PG8_STAGE(PG8_SB(0, 1), cB + hstepB, voffB); PG8_STAGE(PG8_SA(0, 1), cA, ro[1]);
    if (wr == 1) PG8_BAR;
    PG8_WAIT_V(4); PG8_BAR;
    PG8_STAGE(PG8_SB(1, 0), cB + kstep, voffB); PG8_STAGE(PG8_SA(1, 0), cA + kstep, ro[0]); PG8_STAGE(PG8_SB(1, 1), cB + hstepB + kstep, voffB);
    PG8_WAIT_V(6); PG8_BAR;
    for (;;) {
        const bool has_next = S.next(ui + 1, nxt);
        const char* nB = has_next ? (const char*)g.Bt + (size_t)nxt.pn * tstepB : cB;
        if (has_next) PGG_ROWS(rn, nxt.pm); else { _Pragma("unroll") for (int hh = 0; hh < 2; ++hh) _Pragma("unroll") for (int ii = 0; ii < 2; ++ii) rn[hh][ii] = ro[hh][ii]; }
        for (int t = 0; t < nt; t += 2) {
            const bool last = (t == nt - 2);
            const char* a1 = cA + (size_t)(t + 1) * kstep;
            const char* a2 = last ? cA : cA + (size_t)(t + 2) * kstep; const char* b2 = last ? nB : cB + (size_t)(t + 2) * kstep;
            const char* a3 = a2 + kstep; const char* b3 = b2 + kstep;
            PG8_LDB(B0, 0, 0); PG8_SCHED; PG8_LDA(At, 0, 0); PG8_STAGE(PG8_SA(1, 1), a1, ro[1]);
            PG8_WAIT_L(8); PG8_BAR; PG8_WAIT_L(0); PG8_MMA(0, 0, At, B0); PG8_BAR; PG8_SCHED;
            PG8_LDB(B1, 0, 1); PG8_STAGE(PG8_SB(0, 0), b2, voffB);
            PG8_BAR; PG8_WAIT_L(0); PG8_MMA(0, 1, At, B1); PG8_BAR;
            PG8_LDA(At, 0, 1); if (last) PG8_STAGE(PG8_SA(0, 0), a2, rn[0]); else PG8_STAGE(PG8_SA(0, 0), a2, ro[0]);
            PG8_BAR; PG8_WAIT_L(0); PG8_MMA(1, 0, At, B0); PG8_BAR; PG8_SCHED;
            PG8_STAGE(PG8_SB(0, 1), b2 + hstepB, voffB);
            PG8_WAIT_V(6); PG8_BAR; PG8_MMA(1, 1, At, B1); PG8_BAR;
            PG8_LDB(B0, 1, 0); PG8_SCHED; PG8_LDA(At, 1, 0); if (last) PG8_STAGE(PG8_SA(0, 1), a2, rn[1]); else PG8_STAGE(PG8_SA(0, 1), a2, ro[1]);
            PG8_WAIT_L(8); PG8_BAR; PG8_WAIT_L(0); PG8_MMA(0, 0, At, B0); PG8_BAR; PG8_SCHED;
            PG8_LDB(B1, 1, 1); PG8_STAGE(PG8_SB(1, 0), b3, voffB);
            PG8_BAR; PG8_WAIT_L(0); PG8_MMA(0, 1, At, B1); PG8_BAR;
            PG8_LDA(At, 1, 1); if (last) PG8_STAGE(PG8_SA(1, 0), a3, rn[0]); else PG8_STAGE(PG8_SA(1, 0), a3, ro[0]);
            PG8_BAR; PG8_WAIT_L(0); PG8_MMA(1, 0, At, B0); PG8_BAR; PG8_SCHED;
            PG8_STAGE(PG8_SB(1, 1), b3 + hstepB, voffB);
            PG8_WAIT_V(6); PG8_BAR; PG8_MMA(1, 1, At, B1); PG8_BAR;
        }
        { int fr2 = fr, fq2 = fq; asm volatile("" : "+v"(fr2), "+v"(fq2)); E(acc, cur, wr, wc, fr2, fq2); }
        if (!has_next) break;
#pragma unroll
        for (int a = 0; a < 2; ++a)
#pragma unroll
            for (int b = 0; b < 2; ++b)
#pragma unroll
                for (int m = 0; m < 4; ++m)
#pragma unroll
                    for (int n = 0; n < 2; ++n) acc[a][b][m][n] = (f32x4){0.f, 0.f, 0.f, 0.f};
        cur = nxt; cB = nB; ++ui;
#pragma unroll
        for (int hh = 0; hh < 2; ++hh)
#pragma unroll
            for (int ii = 0; ii < 2; ++ii) ro[hh][ii] = rn[hh][ii];
    }
    PG8_WAIT_V(0);
    if (wr == 0) PG8_BAR;
    PG8_BAR;
#undef PGG_ROWS
#undef PG8_SA
#undef PG8_SB
#undef PG8_STAGE
#undef PG8_LDA
#undef PG8_LDB
#undef PG8_MMA
#undef PG8_WAIT_V
#undef PG8_WAIT_L
#undef PG8_BAR
#undef PG8_SCHED
}

typedef f32x4 AccT[2][2][4][2];
__device__ __forceinline__ u32x4 pack8(f32x4 v0, f32x4 v1) { return (u32x4){cvt_pk_bf16(v0[0], v0[1]), cvt_pk_bf16(v0[2], v0[3]), cvt_pk_bf16(v1[0], v1[1]), cvt_pk_bf16(v1[2], v1[3])}; }
struct MergeArgs { const bf16_t* A; const bf16_t* Bt; const bf16_t* gates; bf16_t* merged; int M; };
__device__ __forceinline__ void gemm_phase_merge(LAS unsigned char* lds, const MergeArgs g, const StaticOrder& S) {
    const int tid = opaque_tid(), wid = __builtin_amdgcn_readfirstlane(tid >> 6), lane = tid & 63, wr = wid >> 2, wc = wid & 3, fr = lane & 15, fq = lane >> 4;
    constexpr int K = 1024, nt = 16;
    unsigned voffA[2], voffB[2];
#pragma unroll
    for (int i = 0; i < 2; ++i) { int R, C; stage_rc(tid * 16 + i * 8192, R, C); const int Rb = (R & ~31) + perm32(R & 31);
        voffA[i] = (unsigned)(R * K + C) * 2u; voffB[i] = (unsigned)(Rb * K + C) * 2u; }
    const size_t kstep = (size_t)(BK * 2), hstep = (size_t)HALF * K * 2, tstep = 2 * hstep;
    const unsigned ldsw = (unsigned)wid * 1024u;
    const int aoff = lds_byte(wr * 64 + fr, fq * 8), boff = lds_byte(wc * 32 + fr, fq * 8);
#define PG8_SA(b, h) (((b) * 2 + (h)) * HTB)
#define PG8_SB(b, h) ((4 + (b) * 2 + (h)) * HTB)
#define PG8_STAGE(bufoff, gbase, voff) do { _Pragma("unroll") for (int _i = 0; _i < 2; ++_i) \
        __builtin_amdgcn_global_load_lds((const unsigned*)((const char*)(gbase) + (voff)[_i]), (LAS unsigned*)(lds + (bufoff) + ldsw + _i * 8192), 16, 0, 0); } while (0)
#define PG8_LDA(dst, b, h) do { _Pragma("unroll") for (int m = 0; m < 4; ++m) _Pragma("unroll") for (int k = 0; k < 2; ++k) dst[m][k] = *(const LAS bf16x8*)(lds + PG8_SA(b, h) + aoff + m * 2048 + k * 1024); } while (0)
#define PG8_LDB(dst, b, h) do { _Pragma("unroll") for (int n = 0; n < 2; ++n) _Pragma("unroll") for (int k = 0; k < 2; ++k) dst[n][k] = *(const LAS bf16x8*)(lds + PG8_SB(b, h) + boff + n * 2048 + k * 1024); } while (0)
#define PG8_MMA(ai, bj, At, Bt) do { __builtin_amdgcn_s_setprio(1); _Pragma("unroll") for (int m = 0; m < 4; ++m) _Pragma("unroll") for (int n = 0; n < 2; ++n) _Pragma("unroll") for (int k = 0; k < 2; ++k) \
        acc[ai][bj][m][n] = __builtin_amdgcn_mfma_f32_16x16x32_bf16(Bt[n][k], At[m][k], acc[ai][bj][m][n], 0, 0, 0); __builtin_amdgcn_s_setprio(0); } while (0)
#define PG8_WAIT_V(n) asm volatile("s_waitcnt vmcnt(" #n ")" ::: "memory")
#define PG8_WAIT_L(n) asm volatile("s_waitcnt lgkmcnt(" #n ")" ::: "memory")
#define PG8_BAR __builtin_amdgcn_s_barrier()
#define PG8_SCHED __builtin_amdgcn_sched_barrier(0)
#define PGM_RESCALE(gx, gy) do { int fr2 = fr, fq2 = fq; asm volatile("" : "+v"(fr2), "+v"(fq2)); \
        const bf16_t* gp0_ = g.gates + ((size_t)cur.pm * BM + wr * 64 + fr2) * 3072 + cur.pn * 256 + wc * 32 + 8 * fq2; \
        _Pragma("unroll") for (int ai = 0; ai < 2; ++ai) { u32x4 xw[4][2], yw[4][2]; \
            _Pragma("unroll") for (int m = 0; m < 4; ++m) _Pragma("unroll") for (int bj = 0; bj < 2; ++bj) { const bf16_t* gp = gp0_ + (size_t)(ai * HALF + m * 16) * 3072 + bj * HALF; \
                xw[m][bj] = *(const u32x4*)(gp + (gx) * 1024); yw[m][bj] = *(const u32x4*)(gp + (gy) * 1024); } \
            _Pragma("unroll") for (int m = 0; m < 4; ++m) _Pragma("unroll") for (int bj = 0; bj < 2; ++bj) { float nx[8], ny[8]; unpack8(xw[m][bj], nx); unpack8(yw[m][bj], ny); \
                _Pragma("unroll") for (int e = 0; e < 8; ++e) acc[ai][bj][m][e >> 2][e & 3] *= ny[e] * __builtin_amdgcn_rcpf(nx[e]); } \
            __builtin_amdgcn_sched_barrier(0); } } while (0)
    Unit cur, nxt; int ui = 0;
    if (!S.next(0, cur)) return;
    f32x4 acc[2][2][4][2];
#pragma unroll
    for (int a = 0; a < 2; ++a)
#pragma unroll
        for (int b = 0; b < 2; ++b)
#pragma unroll
            for (int m = 0; m < 4; ++m)
#pragma unroll
                for (int n = 0; n < 2; ++n) acc[a][b][m][n] = (f32x4){0.f, 0.f, 0.f, 0.f};
    bf16x8 At[4][2], B0[2][2], B1[2][2];
    const char* cA = (const char*)g.A + (size_t)cur.pm * tstep; const char* cB = (const char*)g.Bt + (size_t)cur.pn * tstep;
    PG8_STAGE(PG8_SB(0, 0), cB, voffB); PG8_STAGE(PG8_SA(0, 0), cA, voffA); PG8_STAGE(PG8_SB(0, 1), cB + hstep, voffB); PG8_STAGE(PG8_SA(0, 1), cA + hstep, voffA);
    if (wr == 1) PG8_BAR;
    PG8_WAIT_V(4); PG8_BAR;
    PG8_STAGE(PG8_SB(1, 0), cB + kstep, voffB); PG8_STAGE(PG8_SA(1, 0), cA + kstep, voffA); PG8_STAGE(PG8_SB(1, 1), cB + hstep + kstep, voffB);
    PG8_WAIT_V(6); PG8_BAR;
    for (;;) {
        const bool has_next = S.next(ui + 1, nxt);
        const char* nA = has_next ? (const char*)g.A + (size_t)nxt.pm * tstep : cA; const char* nB = has_next ? (const char*)g.Bt + (size_t)nxt.pn * tstep : cB;
#define PGM_ITER(t) do { \
            const bool last = ((t) == nt - 2); \
            const char* a1 = cA + (size_t)((t) + 1) * kstep; \
            const char* a2 = last ? nA : cA + (size_t)((t) + 2) * kstep; const char* b2 = last ? nB : cB + (size_t)((t) + 2) * kstep; \
            const char* a3 = a2 + kstep; const char* b3 = b2 + kstep; \
            PG8_LDB(B0, 0, 0); PG8_SCHED; PG8_LDA(At, 0, 0); PG8_STAGE(PG8_SA(1, 1), a1 + hstep, voffA); \
            PG8_WAIT_L(8); PG8_BAR; PG8_WAIT_L(0); PG8_MMA(0, 0, At, B0); PG8_BAR; PG8_SCHED; \
            PG8_LDB(B1, 0, 1); PG8_STAGE(PG8_SB(0, 0), b2, voffB); \
            PG8_BAR; PG8_WAIT_L(0); PG8_MMA(0, 1, At, B1); PG8_BAR; \
            PG8_LDA(At, 0, 1); PG8_STAGE(PG8_SA(0, 0), a2, voffA); \
            PG8_BAR; PG8_WAIT_L(0); PG8_MMA(1, 0, At, B0); PG8_BAR; PG8_SCHED; \
            PG8_STAGE(PG8_SB(0, 1), b2 + hstep, voffB); \
            PG8_WAIT_V(6); PG8_BAR; PG8_MMA(1, 1, At, B1); PG8_BAR; \
            PG8_LDB(B0, 1, 0); PG8_SCHED; PG8_LDA(At, 1, 0); PG8_STAGE(PG8_SA(0, 1), a2 + hstep, voffA); \
            PG8_WAIT_L(8); PG8_BAR; PG8_WAIT_L(0); PG8_MMA(0, 0, At, B0); PG8_BAR; PG8_SCHED; \
            PG8_LDB(B1, 1, 1); PG8_STAGE(PG8_SB(1, 0), b3, voffB); \
            PG8_BAR; PG8_WAIT_L(0); PG8_MMA(0, 1, At, B1); PG8_BAR; \
            PG8_LDA(At, 1, 1); PG8_STAGE(PG8_SA(1, 0), a3, voffA); \
            PG8_BAR; PG8_WAIT_L(0); PG8_MMA(1, 0, At, B0); PG8_BAR; PG8_SCHED; \
            PG8_STAGE(PG8_SB(1, 1), b3 + hstep, voffB); \
            PG8_WAIT_V(6); PG8_BAR; PG8_MMA(1, 1, At, B1); PG8_BAR; } while (0)
#pragma unroll 1
        for (int t = 0; t < 8; t += 2) PGM_ITER(t);
        PGM_RESCALE(0, 1);
#pragma unroll 1
        for (int t = 8; t < 12; t += 2) PGM_ITER(t);
        PGM_RESCALE(1, 2);
#pragma unroll 1
        for (int t = 12; t < 16; t += 2) PGM_ITER(t);
#undef PGM_ITER
        {
            int fr2 = fr, fq2 = fq; asm volatile("" : "+v"(fr2), "+v"(fq2));
            const size_t row0 = (size_t)cur.pm * BM + wr * 64 + fr2; const int col0 = cur.pn * 256 + wc * 32 + 8 * fq2;
#pragma unroll
            for (int ai = 0; ai < 2; ++ai)
#pragma unroll
                for (int mp = 0; mp < 2; ++mp) { u32x4 gw[2][2];
#pragma unroll
                    for (int mm = 0; mm < 2; ++mm)
#pragma unroll
                        for (int bj = 0; bj < 2; ++bj) gw[mm][bj] = *(const u32x4*)(g.gates + (row0 + ai * HALF + (2 * mp + mm) * 16) * 3072 + 2048 + col0 + bj * HALF);
#pragma unroll
                    for (int mm = 0; mm < 2; ++mm)
#pragma unroll
                        for (int bj = 0; bj < 2; ++bj) { const int m = 2 * mp + mm; float gg[8]; unpack8(gw[mm][bj], gg); f32x4 v0 = acc[ai][bj][m][0], v1 = acc[ai][bj][m][1];
#pragma unroll
                            for (int e = 0; e < 4; ++e) { v0[e] *= __builtin_amdgcn_rcpf(gg[e]); v1[e] *= __builtin_amdgcn_rcpf(gg[4 + e]); }
                            *(u32x4*)(g.merged + (row0 + ai * HALF + m * 16) * 1024 + col0 + bj * HALF) = pack8(v0, v1); }
                    __builtin_amdgcn_sched_barrier(0); }
        }
        if (!has_next) break;
#pragma unroll
        for (int a = 0; a < 2; ++a)
#pragma unroll
            for (int b = 0; b < 2; ++b)
#pragma unroll
                for (int m = 0; m < 4; ++m)
#pragma unroll
                    for (int n = 0; n < 2; ++n) acc[a][b][m][n] = (f32x4){0.f, 0.f, 0.f, 0.f};
        cur = nxt; cA = nA; cB = nB; ++ui;
    }
    PG8_WAIT_V(0);
    if (wr == 0) PG8_BAR;
    PG8_BAR;
#undef PG8_SA
#undef PG8_SB
#undef PG8_STAGE
#undef PGM_RESCALE
#undef PG8_LDA
#undef PG8_LDB
#undef PG8_MMA
#undef PG8_WAIT_V
#undef PG8_WAIT_L
#undef PG8_BAR
#undef PG8_SCHED
}


struct EpiInproj {
    static constexpr bool PERM = true;
    bf16_t* u_att; bf16_t* u_s5; bf16_t* u_rw;
    __device__ __forceinline__ void operator()(const AccT& acc, const Unit& u, int wr, int wc, int fr, int fq) const {
        const int row0 = u.pm * BM + wr * 64 + fr; bf16_t* base; int ld, colt;
        if (u.pn < 4) { base = u_att; ld = 1024; colt = u.pn * 256; } else if (u.pn == 4) { base = u_s5; ld = 256; colt = 0; } else { base = u_rw; ld = 1024; colt = (u.pn - 5) * 256; }
        const int col0 = colt + wc * 32 + 8 * fq;
#pragma unroll
        for (int ai = 0; ai < 2; ++ai)
#pragma unroll
            for (int m = 0; m < 4; ++m) { bf16_t* rowp = base + (size_t)(row0 + ai * HALF + m * 16) * ld + col0;
#pragma unroll
                for (int bj = 0; bj < 2; ++bj) *(u32x4*)(rowp + bj * HALF) = pack8(acc[ai][bj][m][0], acc[ai][bj][m][1]); }
    }
};
struct EpiLora {
    static constexpr bool PERM = true;
    bf16_t* out; const float* w0; const float* a0;
    __device__ __forceinline__ void operator()(const AccT& acc, const Unit& u, int wr, int wc, int fr, int fq) const {
        const int row0 = u.pm * BM + wr * 64 + fr, kind = u.pn; bf16_t* base = out + (size_t)kind * NTOK * 256;
        const int col0 = wc * 32 + 8 * fq;
        const float* bp = kind < 2 ? w0 + kind * 256 : a0 + (kind & 1) * 256;
        const float sc = kind < 2 ? 0.6065306597126334f : 1.0f;
#pragma unroll
        for (int bj = 0; bj < 2; ++bj) {
            f32x4 b0 = (f32x4){0.f, 0.f, 0.f, 0.f}, b1 = b0;
            if (kind < 4) { b0 = *(const f32x4*)(bp + col0 + bj * HALF); b1 = *(const f32x4*)(bp + col0 + bj * HALF + 4); }
#pragma unroll
            for (int ai = 0; ai < 2; ++ai)
#pragma unroll
                for (int m = 0; m < 4; ++m) { bf16_t* rowp = base + (size_t)(row0 + ai * HALF + m * 16) * 256 + col0;
                    f32x4 v0 = acc[ai][bj][m][0] + b0, v1 = acc[ai][bj][m][1] + b1;
                    if (kind < 4) {
#pragma unroll
                        for (int e = 0; e < 4; ++e) { v0[e] = sc * sigmoidf_(v0[e]); v1[e] = sc * sigmoidf_(v1[e]); } }
                    *(u32x4*)(rowp + bj * HALF) = pack8(v0, v1); __builtin_amdgcn_sched_barrier(0); }
        }
    }
};
struct EpiGlu {
    static constexpr bool PERM = true;
    bf16_t* o;
    __device__ __forceinline__ void operator()(const AccT& acc, const Unit& u, int wr, int wc, int fr, int fq) const {
        const int row0 = u.pm * BM + wr * 64 + fr; const int col0 = u.pn * 256 + wc * 32 + 8 * fq;
#pragma unroll
        for (int ai = 0; ai < 2; ++ai)
#pragma unroll
            for (int m = 0; m < 4; ++m) { bf16_t* rowp = o + (size_t)(row0 + ai * HALF + m * 16) * 1024;
#pragma unroll
                for (int bj = 0; bj < 2; ++bj) { const f32x4 v = acc[ai][bj][m][0], gt = acc[ai][bj][m][1]; const int j0 = (col0 + bj * HALF) >> 1;
                    *(u32x2*)(rowp + j0) = (u32x2){cvt_pk_bf16(v[0] * sigmoidf_(gt[0]), v[1] * sigmoidf_(gt[1])), cvt_pk_bf16(v[2] * sigmoidf_(gt[2]), v[3] * sigmoidf_(gt[3]))}; } }
    }
};
struct EpiGates {
    static constexpr bool PERM = true;
    bf16_t* o;
    __device__ __forceinline__ void operator()(const AccT& acc, const Unit& u, int wr, int wc, int fr, int fq) const {
        const int row0 = u.pm * BM + wr * 64 + fr; const int col0 = u.pn * 256 + wc * 32 + 8 * fq;
#pragma unroll
        for (int ai = 0; ai < 2; ++ai)
#pragma unroll
            for (int m = 0; m < 4; ++m) { bf16_t* rowp = o + (size_t)(row0 + ai * HALF + m * 16) * 3072 + col0;
#pragma unroll
                for (int bj = 0; bj < 2; ++bj) { f32x4 v0 = acc[ai][bj][m][0], v1 = acc[ai][bj][m][1];
#pragma unroll
                    for (int e = 0; e < 4; ++e) { v0[e] = fminf(1.0f + __builtin_amdgcn_exp2f(-1.4426950408889634f * v0[e]), 1e30f); v1[e] = fminf(1.0f + __builtin_amdgcn_exp2f(-1.4426950408889634f * v1[e]), 1e30f); }
                    *(u32x4*)(rowp + bj * HALF) = pack8(v0, v1); } }
    }
};
template <bool FIRST> struct EpiMerge {
    static constexpr bool PERM = true;
    bf16_t* merged; const bf16_t* gates; int br;
    __device__ __forceinline__ void operator()(const AccT& acc, const Unit& u, int wr, int wc, int fr, int fq) const {
        const int row0 = u.pm * BM + wr * 64 + fr; const int col0 = u.pn * 256 + wc * 32 + 8 * fq;
#pragma unroll
        for (int ai = 0; ai < 2; ++ai) {
            u32x4 gw[4][2], mw[4][2];
#pragma unroll
            for (int m = 0; m < 4; ++m)
#pragma unroll
                for (int bj = 0; bj < 2; ++bj) { const size_t row = (size_t)(row0 + ai * HALF + m * 16); const int c = col0 + bj * HALF;
                    gw[m][bj] = *(const u32x4*)(gates + row * 3072 + br * 1024 + c);
                    if (!FIRST) mw[m][bj] = *(const u32x4*)(merged + row * 1024 + c); }
#pragma unroll
            for (int m = 0; m < 4; ++m)
#pragma unroll
                for (int bj = 0; bj < 2; ++bj) { const size_t row = (size_t)(row0 + ai * HALF + m * 16); const int c = col0 + bj * HALF;
                    f32x4 v0 = acc[ai][bj][m][0], v1 = acc[ai][bj][m][1]; const u32x4 g = gw[m][bj];
                    v0[0] *= bflo(g[0]); v0[1] *= bfhi(g[0]); v0[2] *= bflo(g[1]); v0[3] *= bfhi(g[1]);
                    v1[0] *= bflo(g[2]); v1[1] *= bfhi(g[2]); v1[2] *= bflo(g[3]); v1[3] *= bfhi(g[3]);
                    if (!FIRST) { const u32x4 w = mw[m][bj];
                        v0[0] += bflo(w[0]); v0[1] += bfhi(w[0]); v0[2] += bflo(w[1]); v0[3] += bfhi(w[1]);
                        v1[0] += bflo(w[2]); v1[1] += bfhi(w[2]); v1[2] += bflo(w[3]); v1[3] += bfhi(w[3]); }
                    *(u32x4*)(merged + row * 1024 + c) = pack8(v0, v1); }
            __builtin_amdgcn_sched_barrier(0);
        }
    }
};
struct EpiResid {
    static constexpr bool PERM = false;
    const float* xin_lat; const float* xin_ctx; float* xout_lat; float* xout_ctx; const float* g1;
    __device__ __forceinline__ void operator()(const AccT& acc, const Unit& u, int wr, int wc, int fr, int fq) const {
        const int rowb = u.pm * BM; const bool lat = rowb < NLAT; const int mr = lat ? (rowb >> 11) : 32;
        const float* xin = lat ? xin_lat + (size_t)rowb * D : xin_ctx + (size_t)(rowb - NLAT) * D;
        float* xo = lat ? xout_lat + (size_t)rowb * D : xout_ctx + (size_t)(rowb - NLAT) * D;
        const int r0 = wr * 64 + fr, col0 = u.pn * BM + wc * 32 + 4 * fq;
        f32x4 gv[2][2];
#pragma unroll
        for (int bj = 0; bj < 2; ++bj)
#pragma unroll
            for (int n = 0; n < 2; ++n) gv[bj][n] = *(const f32x4*)(g1 + (size_t)mr * MODW + col0 + bj * HALF + n * 16);
#pragma unroll
        for (int ai = 0; ai < 2; ++ai) {
            f32x4 xv[4][2][2];
#pragma unroll
            for (int m = 0; m < 4; ++m)
#pragma unroll
                for (int bj = 0; bj < 2; ++bj)
#pragma unroll
                    for (int n = 0; n < 2; ++n) xv[m][bj][n] = *(const f32x4*)(xin + (size_t)(r0 + ai * HALF + m * 16) * D + col0 + bj * HALF + n * 16);
#pragma unroll
            for (int m = 0; m < 4; ++m)
#pragma unroll
                for (int bj = 0; bj < 2; ++bj)
#pragma unroll
                    for (int n = 0; n < 2; ++n) *(f32x4*)(xo + (size_t)(r0 + ai * HALF + m * 16) * D + col0 + bj * HALF + n * 16) = xv[m][bj][n] + gv[bj][n] * acc[ai][bj][m][n];
            __builtin_amdgcn_sched_barrier(0);
        }
    }
};
struct EpiLogits {
    static constexpr bool PERM = false;
    float* o;
    __device__ __forceinline__ void operator()(const AccT& acc, const Unit& u, int wr, int wc, int fr, int fq) const {
        if (wc >= 2) return;
        const int row0 = u.pm * BM + wr * 64 + fr, col0 = wc * 32 + 4 * fq;
#pragma unroll
        for (int ai = 0; ai < 2; ++ai)
#pragma unroll
            for (int m = 0; m < 4; ++m) { float* rowp = o + (size_t)(row0 + ai * HALF + m * 16) * 64 + col0;
#pragma unroll
                for (int n = 0; n < 2; ++n) *(f32x4*)(rowp + n * 16) = acc[ai][0][m][n]; }
    }
};
struct EpiGU {
    static constexpr bool PERM = true;
    bf16_t* o;
    __device__ __forceinline__ void operator()(const AccT& acc, const Unit& u, int wr, int wc, int fr, int fq) const {
        const int row0 = u.pm * BM + wr * 64 + fr; const int col0 = (u.pn & 3) * 256 + wc * 32 + 8 * fq;
#pragma unroll
        for (int ai = 0; ai < 2; ++ai)
#pragma unroll
            for (int m = 0; m < 4; ++m) { bf16_t* rowp = o + (size_t)(row0 + ai * HALF + m * 16) * 512;
#pragma unroll
                for (int bj = 0; bj < 2; ++bj) { const f32x4 gt = acc[ai][bj][m][0], up = acc[ai][bj][m][1]; const int j0 = (col0 + bj * HALF) >> 1;
                    *(u32x2*)(rowp + j0) = (u32x2){cvt_pk_bf16(gt[0] * sigmoidf_(gt[0]) * up[0], gt[1] * sigmoidf_(gt[1]) * up[1]), cvt_pk_bf16(gt[2] * sigmoidf_(gt[2]) * up[2], gt[3] * sigmoidf_(gt[3]) * up[3])}; } }
    }
};
struct EpiDown {
    static constexpr bool PERM = true;
    bf16_t* o; const float* sgate;
    __device__ __forceinline__ void operator()(const AccT& acc, const Unit& u, int wr, int wc, int fr, int fq) const {
        const int row0 = u.pm * BM + wr * 64 + fr; const int col0 = (u.pn & 3) * 256 + wc * 32 + 8 * fq;
#pragma unroll
        for (int ai = 0; ai < 2; ++ai)
#pragma unroll
            for (int m = 0; m < 4; ++m) { const int row = row0 + ai * HALF + m * 16; const float w = sgate[row]; bf16_t* rowp = o + (size_t)row * 1024 + col0;
#pragma unroll
                for (int bj = 0; bj < 2; ++bj) *(u32x4*)(rowp + bj * HALF) = pack8(acc[ai][bj][m][0] * w, acc[ai][bj][m][1] * w); }
    }
};
}

__device__ __forceinline__ void phase_mod(unsigned char* shm, const float* c, const float* c_ctx, const float* w_mod, const float* b_mod, float* mod) {
    const int tid = opaque_tid();
    float* s = (float*)shm;
    for (int idx = tid; idx < 33 * 1024; idx += 512) { const int r = idx >> 10, k = idx & 1023; const float v = (r < 32) ? c[r * 1024 + k] : c_ctx[k]; s[idx] = v / (1.0f + __expf(-v)); }
    __syncthreads();
    const int j = tid & 63, kc = tid >> 6;
    for (int u = blockIdx.x; u < 2 * 96; u += gridDim.x) {
        const int l = u / 96, col0 = (u % 96) * 64;
        float acc[33];
#pragma unroll
        for (int r = 0; r < 33; ++r) acc[r] = 0.f;
        const float* wp = w_mod + (size_t)l * D * MODW + col0 + j;
        for (int k = kc * 128; k < kc * 128 + 128; k += 4) {
            const float w0 = wp[(size_t)k * MODW], w1 = wp[(size_t)(k + 1) * MODW], w2 = wp[(size_t)(k + 2) * MODW], w3 = wp[(size_t)(k + 3) * MODW];
#pragma unroll
            for (int r = 0; r < 33; ++r) { const f32x4 sv = *(const f32x4*)(s + r * 1024 + k); acc[r] += sv[0] * w0 + sv[1] * w1 + sv[2] * w2 + sv[3] * w3; }
        }
        float* acc_s = (float*)(shm + 135168);
        for (int w = 0; w < 8; ++w) {
            if (kc == w) {
#pragma unroll
                for (int r = 0; r < 33; ++r) { if (w == 0) acc_s[r * 64 + j] = acc[r]; else acc_s[r * 64 + j] += acc[r]; }
            }
            __syncthreads();
        }
        for (int o = tid; o < 33 * 64; o += 512) { const int r = o >> 6, jj = o & 63; mod[((size_t)l * 33 + r) * MODW + col0 + jj] = acc_s[o] + b_mod[l * MODW + col0 + jj]; }
        __syncthreads();
    }
}

template <int MAP  >
__device__ __forceinline__ void cvt_tile(unsigned char* shm, const float* src, int ldS, int k0, int n0, bf16_t* dst, int ldD, int kdst0, int nrow0, int half) {
    float* tile = (float*)shm;
    const int tid = opaque_tid();
    {
        const int kk = tid >> 4, nn = (tid & 15) * 4;
#pragma unroll
        for (int p = 0; p < 2; ++p) { const int k = kk + p * 32;
            f32x4 v = (f32x4){0.f, 0.f, 0.f, 0.f}; if (src) v = *(const f32x4*)(src + (size_t)(k0 + k) * ldS + n0 + nn);
            tile[k * 65 + nn] = v[0]; tile[k * 65 + nn + 1] = v[1]; tile[k * 65 + nn + 2] = v[2]; tile[k * 65 + nn + 3] = v[3]; }
    }
    __syncthreads();
    {
        const int nn = tid >> 3, k8 = (tid & 7) * 8; int n = n0 + nn;
        if (MAP == 1) { const int hh = n >= half ? 1 : 0, jj = n - hh * half; n = 8 * (jj >> 2) + 4 * hh + (jj & 3); }
        float v[8];
#pragma unroll
        for (int i = 0; i < 8; ++i) v[i] = tile[(k8 + i) * 65 + nn];
        *(u32x4*)(dst + (size_t)(nrow0 + n) * ldD + kdst0 + k8) = (u32x4){cvt_pk_bf16(v[0], v[1]), cvt_pk_bf16(v[2], v[3]), cvt_pk_bf16(v[4], v[5]), cvt_pk_bf16(v[6], v[7])};
    }
    __syncthreads();
}
template <int MAP>
__device__ __forceinline__ void cvt_tile4(unsigned char* shm, const float* src, int ldS, int k0, int n0, bf16_t* dst, int ldD, int kdst0, int nrow0, int half) {
    float* tile = (float*)shm;
    const int tid = opaque_tid();
    {
        const int kk = tid >> 6, nn = (tid & 63) * 4;
        f32x4 v[8];
#pragma unroll
        for (int p = 0; p < 8; ++p) v[p] = *(const f32x4*)(src + (size_t)(k0 + kk + 8 * p) * ldS + n0 + nn);
#pragma unroll
        for (int p = 0; p < 8; ++p) { float* tp = tile + (kk + 8 * p) * 257 + nn; tp[0] = v[p][0]; tp[1] = v[p][1]; tp[2] = v[p][2]; tp[3] = v[p][3]; }
    }
    __syncthreads();
    {
        const int nn = tid >> 1, kh = (tid & 1) * 32; int n = n0 + nn;
        if (MAP == 1) { const int hh = n >= half ? 1 : 0, jj = n - hh * half; n = 8 * (jj >> 2) + 4 * hh + (jj & 3); }
        bf16_t* dp = dst + (size_t)(nrow0 + n) * ldD + kdst0 + kh;
#pragma unroll
        for (int q = 0; q < 4; ++q) { float v[8];
#pragma unroll
            for (int i = 0; i < 8; ++i) v[i] = tile[(kh + 8 * q + i) * 257 + nn];
            *(u32x4*)(dp + 8 * q) = (u32x4){cvt_pk_bf16(v[0], v[1]), cvt_pk_bf16(v[2], v[3]), cvt_pk_bf16(v[4], v[5]), cvt_pk_bf16(v[6], v[7])}; }
    }
    __syncthreads();
}
__device__ __forceinline__ void phase_cvt_small(unsigned char* shm, LAS unsigned char* lds, int l, bf16_t* W) {
    const float* w_in = INP(7) + (size_t)l * D * INW;
    const float* w_glu = INP(18) + (size_t)l * 256 * 512;
    const float* w2 = INP(21) + (size_t)l * 2 * 64 * 256;
    const float* a2 = INP(23) + (size_t)l * 2 * 64 * 256;
    const float* g2 = INP(24) + (size_t)l * 128 * 256;
    const float* p_att = INP(30) + (size_t)l * 512 * 1024;
    const float* p_s5 = INP(31) + (size_t)l * 256 * 1024;
    const float* p_rw = INP(32) + (size_t)l * 256 * 1024;
    const float* w_out = INP(33) + (size_t)l * 1024 * 1024;
    constexpr int T_IN = 16 * 21, T_GLU = 4 * 2, T_PA = 8 * 4, T_PS = 4 * 4, T_PR = 4 * 4, T_OUT = 16 * 4, T_LORA = 20 * 4;
    constexpr int E_IN = T_IN, E_GLU = E_IN + T_GLU, E_PA = E_GLU + T_PA, E_PS = E_PA + T_PS, E_PR = E_PS + T_PR, E_OUT = E_PR + T_OUT, E_LORA = E_OUT + T_LORA;
    for (int t = blockIdx.x; t < E_LORA; t += gridDim.x) {
        if (t < E_IN) { const int tk = t / 21, tn = t % 21; cvt_tile4<0>(shm, w_in, INW, tk * 64, tn * 256, W + SW_IN, 1024, tk * 64, 0, 0); }
        else if (t < E_GLU) { const int q = t - E_IN, tk = q / 2, tn = q % 2; cvt_tile4<1>(shm, w_glu, 512, tk * 64, tn * 256, W + SW_GLU, 256, tk * 64, 0, 256); }
        else if (t < E_PA) { const int q = t - E_GLU, tk = q / 4, tn = q % 4; cvt_tile4<0>(shm, p_att, 1024, tk * 64, tn * 256, W + SW_PA, 1024, tk * 64, 0, 0); }
        else if (t < E_PS) { const int q = t - E_PA, tk = q / 4, tn = q % 4; cvt_tile4<0>(shm, p_s5, 1024, tk * 64, tn * 256, W + SW_PA, 1024, 512 + tk * 64, 0, 0); }
        else if (t < E_PR) { const int q = t - E_PS, tk = q / 4, tn = q % 4; cvt_tile4<0>(shm, p_rw, 1024, tk * 64, tn * 256, W + SW_PA, 1024, 768 + tk * 64, 0, 0); }
        else if (t < E_OUT) { const int q = t - E_PR, tk = q / 4, tn = q % 4; cvt_tile4<0>(shm, w_out, 1024, tk * 64, tn * 256, W + SW_OUT, 1024, tk * 64, 0, 0); }
        else { const int q = t - E_OUT, tn = q / 4, tk = q % 4, seg = tn / 4, tnl = tn % 4;
            const float* src = nullptr; int k0 = 0;
            if (seg < 2) { if (tk == 0) { src = w2 + (size_t)seg * 64 * 256; k0 = 0; } }
            else if (seg < 4) { if (tk == 1) { src = a2 + (size_t)(seg - 2) * 64 * 256; k0 = 0; } }
            else { if (tk >= 2) { src = g2; k0 = (tk - 2) * 64; } }
            cvt_tile<0>(shm, src, 256, k0, tnl * 64, W + SW_LORA, 256, tk * 64, seg * 256, 0); }
    }
    const float* rg = INP(35) + (size_t)l * 1024 * 4; const float* re = INP(37) + (size_t)l * 1024 * 32;
    for (int idx = blockIdx.x * 512 + opaque_tid(); idx < 256 * 1024; idx += gridDim.x * 512) { const int n = idx >> 10, k = idx & 1023;
        const float v = n < 4 ? rg[k * 4 + n] : n < 36 ? re[k * 32 + n - 4] : 0.f; W[SW_RT + idx] = f2bf(v); }
}
__device__ __forceinline__ void phase_cvt_experts(unsigned char* shm, LAS unsigned char* lds, int l, bf16_t* Wgu, bf16_t* Wdn) {
    const float* wg = INP(39) + (size_t)l * NEXP * D * FEXP; const float* wu = INP(40) + (size_t)l * NEXP * D * FEXP; const float* wd = INP(41) + (size_t)l * NEXP * FEXP * D;
    for (int t = blockIdx.x; t < NEXP * 96; t += gridDim.x) {
        const int e = t / 96, q = t % 96;
        if (q < 32) { const int tk = q >> 1, tn = q & 1;
            cvt_tile4<1>(shm, wg + (size_t)e * D * FEXP, FEXP, tk * 64, tn * 256, Wgu + (size_t)e * 1024 * 1024, 1024, tk * 64, 0, 1 << 30); }
        else if (q < 64) { const int qq = q - 32, tk = qq >> 1, tn = qq & 1;
            cvt_tile4<1>(shm, wu + (size_t)e * D * FEXP, FEXP, tk * 64, tn * 256, Wgu + (size_t)e * 1024 * 1024 + 4 * 1024, 1024, tk * 64, 0, 1 << 30); }
        else { const int qq = q - 64, tk = qq >> 2, tn = qq & 3;
            cvt_tile4<0>(shm, wd + (size_t)e * FEXP * D, D, tk * 64, tn * 256, Wdn + (size_t)e * 1024 * 512, 512, tk * 64, 0, 0); }
    }
}
__device__ __forceinline__ void phase_rope(float* rope) {
    const int idx = blockIdx.x * 512 + opaque_tid();
    if (idx < 1024) { const int pos = idx >> 4, i = idx & 15;
        const double base[4] = {1.0, 0.5623413251903491, 0.31622776601683794, 0.17782794100389228};
        double inv = (i & 3) == 0 ? base[0] : (i & 3) == 1 ? base[1] : (i & 3) == 2 ? base[2] : base[3];
        inv *= (i >> 2) == 0 ? 1.0 : (i >> 2) == 1 ? 0.1 : (i >> 2) == 2 ? 0.01 : 0.001;
        const double ang = (double)((float)pos * (float)inv); double s, c; sincos_d(ang, s, c);
        rope[idx * 2] = (float)c; rope[idx * 2 + 1] = (float)s; }
}

__device__ __forceinline__ void phase_norm(const float* src_lat, const float* src_ctx, int nrows, const float* gamma, const float* modl, int sh_off, int sc_off, bf16_t* hdst,
                                           bool comb, const float* modprev, const int* pos, const bf16_t* oslot, float* wb_lat, float* wb_ctx) {
    const int tid_ = opaque_tid(), lane = tid_ & 63, wid = tid_ >> 6;
    const int nwave = gridDim.x * 8, per = (nrows + nwave - 1) / nwave, r0 = (blockIdx.x * 8 + wid) * per, r1 = min(nrows, r0 + per);
    int row = r0;
    f32x4 v[4]; int p0 = 0, p1 = 0;
#define PN_LOAD(r_, vv, q0, q1) do { const bool lat_ = (r_) < NLAT; const float* sp_ = lat_ ? src_lat + (size_t)(r_) * D : src_ctx + (size_t)((r_) - NLAT) * D; \
        _Pragma("unroll") for (int q = 0; q < 4; ++q) vv[q] = *(const f32x4*)(sp_ + q * 256 + lane * 4); \
        if (comb) { q0 = pos[(r_) * 2]; q1 = pos[(r_) * 2 + 1]; } } while (0)
    if (row < r1) PN_LOAD(row, v, p0, p1);
    int mrc = -1;
    f32x4 gmv[4], scv[4], shv[4], g2v[4];
#pragma unroll
    for (int q = 0; q < 4; ++q) { gmv[q] = scv[q] = shv[q] = g2v[q] = (f32x4){0.f, 0.f, 0.f, 0.f}; if (hdst) gmv[q] = *(const f32x4*)(gamma + q * 256 + lane * 4); }
    while (row < r1) {
        const int nrow = row + 1;
        f32x4 vn[4]; int pn0 = 0, pn1 = 0;
        u32x2 o0[4], o1[4];
        const bool lat = row < NLAT; const int mr = lat ? (row >> 11) : 32;
        if (comb) {
#pragma unroll
            for (int q = 0; q < 4; ++q) { const int c = q * 256 + lane * 4; o0[q] = *(const u32x2*)(oslot + (size_t)p0 * D + c); o1[q] = *(const u32x2*)(oslot + (size_t)p1 * D + c); }
        }
        if (nrow < r1) PN_LOAD(nrow, vn, pn0, pn1);
        if (mr != mrc) { mrc = mr;
#pragma unroll
            for (int q = 0; q < 4; ++q) { const int c = q * 256 + lane * 4;
                if (hdst) { scv[q] = *(const f32x4*)(modl + (size_t)mr * MODW + sc_off + c); shv[q] = *(const f32x4*)(modl + (size_t)mr * MODW + sh_off + c); }
                if (comb) g2v[q] = *(const f32x4*)(modprev + (size_t)mr * MODW + 5 * D + c); } }
        if (comb) {
#pragma unroll
            for (int q = 0; q < 4; ++q) { const f32x4 g2 = g2v[q];
                v[q][0] += g2[0] * (bflo(o0[q][0]) + bflo(o1[q][0])); v[q][1] += g2[1] * (bfhi(o0[q][0]) + bfhi(o1[q][0]));
                v[q][2] += g2[2] * (bflo(o0[q][1]) + bflo(o1[q][1])); v[q][3] += g2[3] * (bfhi(o0[q][1]) + bfhi(o1[q][1])); }
            if (wb_lat) { float* wp = lat ? wb_lat + (size_t)row * D : wb_ctx + (size_t)(row - NLAT) * D;
#pragma unroll
                for (int q = 0; q < 4; ++q) *(f32x4*)(wp + q * 256 + lane * 4) = v[q]; }
        }
        if (hdst) {
            float ss = 0.f;
#pragma unroll
            for (int q = 0; q < 4; ++q) ss += v[q][0] * v[q][0] + v[q][1] * v[q][1] + v[q][2] * v[q][2] + v[q][3] * v[q][3];
            ss = wave_sum(ss);
            const float rs = rsqrtf(ss * (1.0f / D) + EPS);
#pragma unroll
            for (int q = 0; q < 4; ++q) { const int c = q * 256 + lane * 4;
                const f32x4 gm = gmv[q], sc = scv[q], sh = shv[q];
                f32x4 y;
#pragma unroll
                for (int e = 0; e < 4; ++e) y[e] = v[q][e] * rs * gm[e] * (1.0f + sc[e]) + sh[e];
                *(u32x2*)(hdst + (size_t)row * D + c) = (u32x2){cvt_pk_bf16(y[0], y[1]), cvt_pk_bf16(y[2], y[3])}; }
        }
#pragma unroll
        for (int q = 0; q < 4; ++q) v[q] = vn[q];
        p0 = pn0; p1 = pn1; row = nrow;
    }
#undef PN_LOAD
}

__device__ __forceinline__ void phase_prep(unsigned char* shm, bf16_t* qkv, bf16_t* vt, const bf16_t* urw, bf16_t* streams, bf16_t* alora,
                                           const float* q_gain, const float* k_gain, const float* rope, const float* convw, const float* k_k) {
    const int tid = opaque_tid(), lane = tid & 63, wid = tid >> 6;
    {
        bf16_t* tile = (bf16_t*)shm;
        for (int u = blockIdx.x; u < NB * 36; u += gridDim.x) {
            const int b = u / 36, kt = u % 36;
            { const int key = tid >> 3, piece = tid & 7; const int n = kt * 64 + key; const int row = n < CTX ? NLAT + b * CTX + n : b * SEQ + n - CTX;
#pragma unroll
              for (int p = 0; p < 4; ++p) { const u32x4 w = *(const u32x4*)(qkv + (size_t)row * 1024 + 768 + (piece + 8 * p) * 8); *(u32x4*)(tile + key * 264 + (piece + 8 * p) * 8) = w; } }
            __syncthreads();
            { const int ch = tid >> 1, half = tid & 1;
              bf16_t* dst = vt + ((size_t)(b * 4) * 64 + ch) * NKEY + kt * 64 + half * 32;
#pragma unroll
              for (int g = 0; g < 4; ++g) { unsigned w[4];
#pragma unroll
                  for (int jp = 0; jp < 4; ++jp) { unsigned lo, hi;
                      { const int s = g * 8 + jp * 2, sl = s & 15, ko = ((sl >> 2) & 1) * 8 + ((sl >> 3) & 1) * 4 + (sl & 3); lo = tile[(half * 32 + (s & 16) + ko) * 264 + ch]; }
                      { const int s = g * 8 + jp * 2 + 1, sl = s & 15, ko = ((sl >> 2) & 1) * 8 + ((sl >> 3) & 1) * 4 + (sl & 3); hi = tile[(half * 32 + (s & 16) + ko) * 264 + ch]; }
                      w[jp] = lo | (hi << 16); }
                  *(u32x4*)(dst + g * 8) = (u32x4){w[0], w[1], w[2], w[3]}; } }
            __syncthreads();
        }
    }
    {
        const int rstride = gridDim.x * 8, rfirst = blockIdx.x * 8 + wid;
        const int sub = lane & 7, d0 = sub * 8;
        float gq[2][8], rcs[8], rsn[8];
#pragma unroll
        for (int pass = 0; pass < 2; ++pass) { const int hh = (lane >> 3) + 8 * pass; const float* gp = (hh < 8 ? q_gain : k_gain) + d0; const f32x4 a = *(const f32x4*)gp, b4 = *(const f32x4*)(gp + 4);
#pragma unroll
            for (int i = 0; i < 4; ++i) { gq[pass][i] = a[i] * (hh < 8 ? 0.125f * LOG2E : 1.0f); gq[pass][4 + i] = b4[i] * (hh < 8 ? 0.125f * LOG2E : 1.0f); } }
        { const int t = rfirst & (SEQ - 1), prow = t >> 6, pcol = t & 63; const int ps = (sub < 4) ? prow : pcol; const int i0 = (sub & 1) * 8; const float* rp = rope + (ps * 16 + i0) * 2;
#pragma unroll
          for (int i = 0; i < 4; ++i) { const f32x4 v = *(const f32x4*)(rp + 4 * i); rcs[2 * i] = v[0]; rsn[2 * i] = v[1]; rcs[2 * i + 1] = v[2]; rsn[2 * i + 1] = v[3]; } }
        const bool first = (sub & 2) == 0;
        u32x4 wnx[3][2];
#pragma unroll
        for (int k = 0; k < 3; ++k) { const int r_ = rfirst + k * rstride; wnx[k][0] = wnx[k][1] = (u32x4){0u, 0u, 0u, 0u};
            if (r_ < NTOK) { wnx[k][0] = *(const u32x4*)(qkv + (size_t)r_ * 1024 + (lane >> 3) * 64 + d0); if ((lane >> 3) < 4) wnx[k][1] = *(const u32x4*)(qkv + (size_t)r_ * 1024 + ((lane >> 3) + 8) * 64 + d0); } }
        for (int row = rfirst; row < NTOK; row += rstride) {
            const bool lat = row < NLAT;
            const u32x4 wcur[2] = {wnx[0][0], wnx[0][1]};
#pragma unroll
            for (int k = 0; k < 2; ++k) { wnx[k][0] = wnx[k + 1][0]; wnx[k][1] = wnx[k + 1][1]; }
            { const int nrow = row + 3 * rstride;
              if (nrow < NTOK) { wnx[2][0] = *(const u32x4*)(qkv + (size_t)nrow * 1024 + (lane >> 3) * 64 + d0); if ((lane >> 3) < 4) wnx[2][1] = *(const u32x4*)(qkv + (size_t)nrow * 1024 + ((lane >> 3) + 8) * 64 + d0); } }
#pragma unroll
            for (int pass = 0; pass < 2; ++pass) {
                const int hh = (lane >> 3) + 8 * pass;
                if (hh < 12) {
                    bf16_t* p = qkv + (size_t)row * 1024 + hh * 64 + d0;
                    const u32x4 w = wcur[pass];
                    float x[8] = {bflo(w[0]), bfhi(w[0]), bflo(w[1]), bfhi(w[1]), bflo(w[2]), bfhi(w[2]), bflo(w[3]), bfhi(w[3])};
                    float ss = 0.f;
#pragma unroll
                    for (int i = 0; i < 8; ++i) ss += x[i] * x[i];
                    ss = sum8(ss);
                    const float rs = rsqrtf(ss * (1.0f / 64.0f) + EPS);
#pragma unroll
                    for (int i = 0; i < 8; ++i) x[i] = x[i] * rs * gq[pass][i];
                    if (lat) {
                        if ((rstride & (SEQ - 1)) != 0) {
                            const int t = row & (SEQ - 1), prow = t >> 6, pcol = t & 63; const int ps = (sub < 4) ? prow : pcol; const int i0 = (sub & 1) * 8; const float* rp = rope + (ps * 16 + i0) * 2;
#pragma unroll
                            for (int i = 0; i < 4; ++i) { const f32x4 v = *(const f32x4*)(rp + 4 * i); rcs[2 * i] = v[0]; rsn[2 * i] = v[1]; rcs[2 * i + 1] = v[2]; rsn[2 * i + 1] = v[3]; } }
                        float xo[8];
#pragma unroll
                        for (int i = 0; i < 8; ++i) xo[i] = dpp<0x4E>(x[i]);
#pragma unroll
                        for (int i = 0; i < 8; ++i) x[i] = first ? (x[i] * rcs[i] - xo[i] * rsn[i]) : (x[i] * rcs[i] + xo[i] * rsn[i]);
                    }
                    *(u32x4*)p = (u32x4){cvt_pk_bf16(x[0], x[1]), cvt_pk_bf16(x[2], x[3]), cvt_pk_bf16(x[4], x[5]), cvt_pk_bf16(x[6], x[7])};
                }
            }
        }
    }
#ifndef REP_PREPC
#define REP_PREPC 1
#endif
    for (int rpc_ = 0; rpc_ < REP_PREPC; ++rpc_)
    {
        const int nwave = gridDim.x * 8, per = (NTOK + nwave - 1) / nwave, r0 = (blockIdx.x * 8 + wid) * per, r1 = min(NTOK, r0 + per);
        const u32x4 z4 = (u32x4){0u, 0u, 0u, 0u};
        u32x4 wp[2] = {z4, z4}, wc[2] = {z4, z4}, wn[2] = {z4, z4}, w2[2] = {z4, z4}, w3[2] = {z4, z4};
        if (r0 < r1) {
#pragma unroll
            for (int q = 0; q < 2; ++q) { if (r0 > 0) wp[q] = *(const u32x4*)(urw + (size_t)(r0 - 1) * 1024 + q * 512 + lane * 8); wc[q] = *(const u32x4*)(urw + (size_t)r0 * 1024 + q * 512 + lane * 8);
                if (r0 + 1 < NTOK) wn[q] = *(const u32x4*)(urw + (size_t)(r0 + 1) * 1024 + q * 512 + lane * 8);
                if (r0 + 2 < NTOK) w2[q] = *(const u32x4*)(urw + (size_t)(r0 + 2) * 1024 + q * 512 + lane * 8); }
        }
        for (int row = r0; row < r1; ++row) {
            const bool lat = row < NLAT; const int t = lat ? (row & (SEQ - 1)) : ((row - NLAT) & (CTX - 1)); const int len = lat ? SEQ : CTX;
            const bool hasp = t > 0, hasn = t < len - 1;
            if (row + 3 < NTOK) {
#pragma unroll
                for (int q = 0; q < 2; ++q) w3[q] = *(const u32x4*)(urw + (size_t)(row + 3) * 1024 + q * 512 + lane * 8);
            }
            float kkn[8];
#pragma unroll
            for (int q = 0; q < 2; ++q) {
                const int ch = q * 512 + lane * 8;
                const u32x4 xp = hasp ? wp[q] : z4, xc = wc[q], xn = hasn ? wn[q] : z4;
                float z[8];
#pragma unroll
                for (int i = 0; i < 4; ++i) {
                    const int c0 = ch + 2 * i;
                    z[2 * i] = bflo(xp[i]) * convw[c0] + bflo(xc[i]) * convw[1024 + c0] + bflo(xn[i]) * convw[2048 + c0];
                    z[2 * i + 1] = bfhi(xp[i]) * convw[c0 + 1] + bfhi(xc[i]) * convw[1024 + c0 + 1] + bfhi(xn[i]) * convw[2048 + c0 + 1];
                }
                if (q == 0) {
                    const int sidx = lane < 32 ? 0 : 1; const int cc = ch - sidx * 256;
                    *(u32x4*)(streams + (size_t)sidx * NTOK * 256 + (size_t)row * 256 + cc) = (u32x4){cvt_pk_bf16(z[0], z[1]), cvt_pk_bf16(z[2], z[3]), cvt_pk_bf16(z[4], z[5]), cvt_pk_bf16(z[6], z[7])};
                    float ss = 0.f;
#pragma unroll
                    for (int i = 0; i < 8; ++i) { kkn[i] = z[i] * k_k[cc + i]; ss += kkn[i] * kkn[i]; }
                    ss = sum8(ss);
                    const float rn = rsqrtf(ss + 1e-12f);
                    if (lane >= 32) *(u32x4*)(streams + (size_t)3 * NTOK * 256 + (size_t)row * 256 + cc) =
                        (u32x4){cvt_pk_bf16(kkn[0] * rn, kkn[1] * rn), cvt_pk_bf16(kkn[2] * rn, kkn[3] * rn), cvt_pk_bf16(kkn[4] * rn, kkn[5] * rn), cvt_pk_bf16(kkn[6] * rn, kkn[7] * rn)};
                } else {
                    if (lane < 32) {
                        *(u32x4*)(streams + (size_t)2 * NTOK * 256 + (size_t)row * 256 + (ch - 512)) = (u32x4){cvt_pk_bf16(z[0], z[1]), cvt_pk_bf16(z[2], z[3]), cvt_pk_bf16(z[4], z[5]), cvt_pk_bf16(z[6], z[7])};
                    } else {
                        const int cc = ch - 768;
#pragma unroll
                        for (int i = 0; i < 8; ++i) { if (cc < 64) { const float e2 = __expf(-2.0f * fabsf(z[i])); const float th = (1.0f - e2) * __builtin_amdgcn_rcpf(1.0f + e2); z[i] = z[i] < 0.f ? -th : th; } else if (cc >= 128) z[i] = sigmoidf_(z[i]); }
                        *(u32x4*)(alora + (size_t)row * 256 + cc) = (u32x4){cvt_pk_bf16(z[0], z[1]), cvt_pk_bf16(z[2], z[3]), cvt_pk_bf16(z[4], z[5]), cvt_pk_bf16(z[6], z[7])};
                    }
                }
            }
#pragma unroll
            for (int q = 0; q < 2; ++q) { wp[q] = wc[q]; wc[q] = wn[q]; wn[q] = w2[q]; w2[q] = w3[q]; }
        }
    }
}

__device__ __forceinline__ void rwkv_chain(LAS unsigned char* lds, int b, int h, int d, const bf16_t* streams, const bf16_t* lora, const float* k_a, bf16_t* yout) {
    const int tid = opaque_tid(), lane = tid & 63, wv = tid >> 6;
    LAS float* ybuf = (LAS float*)(lds + 98304);
    const bf16_t* Rp = streams, *Kp = streams + (size_t)NTOK * 256, *Vp = streams + (size_t)2 * NTOK * 256, *KKp = streams + (size_t)3 * NTOK * 256;
    const bf16_t* Ep = lora + (size_t)d * NTOK * 256, *Ap = lora + (size_t)(2 + d) * NTOK * 256;
    const int st = tid >> 4, c4 = (tid & 15) * 4;
    const f32x4 ka4 = *(const f32x4*)(k_a + h * 64 + c4);
    u32x2 g0, g1, g2, g3, g4, g5;
#define RW_GLOAD(blk) do { const size_t off = (size_t)seq_row(b, d, (blk) * 32 + st) * 256 + h * 64 + c4; \
        g0 = *(const u32x2*)(Rp + off); g1 = *(const u32x2*)(Kp + off); g2 = *(const u32x2*)(Vp + off); g3 = *(const u32x2*)(KKp + off); g4 = *(const u32x2*)(Ep + off); g5 = *(const u32x2*)(Ap + off); } while (0)
#define RW_LSTORE(bufp) do { LAS float* _bp = (bufp) + st * 64 + c4; \
        const f32x4 r_ = (f32x4){bflo(g0[0]), bfhi(g0[0]), bflo(g0[1]), bfhi(g0[1])}, k_ = (f32x4){bflo(g1[0]), bfhi(g1[0]), bflo(g1[1]), bfhi(g1[1])}; \
        const f32x4 v_ = (f32x4){bflo(g2[0]), bfhi(g2[0]), bflo(g2[1]), bfhi(g2[1])}, kk_ = (f32x4){bflo(g3[0]), bfhi(g3[0]), bflo(g3[1]), bfhi(g3[1])}; \
        const f32x4 e_ = (f32x4){bflo(g4[0]), bfhi(g4[0]), bflo(g4[1]), bfhi(g4[1])}, a_ = (f32x4){bflo(g5[0]), bfhi(g5[0]), bflo(g5[1]), bfhi(g5[1])}; \
        f32x4 w_, kt_; _Pragma("unroll") for (int _e = 0; _e < 4; ++_e) { w_[_e] = __expf(-e_[_e]); kt_[_e] = k_[_e] * (1.0f + (a_[_e] - 1.0f) * ka4[_e]); } \
        *(LAS f32x4*)(_bp) = w_; *(LAS f32x4*)(_bp + 2048) = kk_ * a_; *(LAS f32x4*)(_bp + 4096) = kt_; *(LAS f32x4*)(_bp + 6144) = kk_; *(LAS f32x4*)(_bp + 8192) = r_; *(LAS f32x4*)(_bp + 10240) = v_; } while (0)
    float S[8];
#pragma unroll
    for (int j = 0; j < 8; ++j) S[j] = 0.f;
    const int c8 = lane & 7, irow = wv * 8 + (lane >> 3);
    RW_GLOAD(0); RW_LSTORE((LAS float*)lds);
    __syncthreads();
    for (int blk = 0; blk < NKEY / 32; ++blk) {
        LAS float* cur = (LAS float*)(lds + (blk & 1) * 49152);
        LAS float* nxt = (LAS float*)(lds + ((blk + 1) & 1) * 49152);
        if (blk + 1 < NKEY / 32) RW_GLOAD(blk + 1);
#pragma unroll 4
        for (int s = 0; s < 32; ++s) {
            LAS float* sp = cur + s * 64 + c8 * 8;
            const f32x4 wA = *(LAS f32x4*)(sp), wB = *(LAS f32x4*)(sp + 4);
            const f32x4 qA = *(LAS f32x4*)(sp + 2048), qB = *(LAS f32x4*)(sp + 2052);
            const f32x4 tA = *(LAS f32x4*)(sp + 4096), tB = *(LAS f32x4*)(sp + 4100);
            const f32x4 kA = *(LAS f32x4*)(sp + 6144), kB = *(LAS f32x4*)(sp + 6148);
            const f32x4 rA = *(LAS f32x4*)(sp + 8192), rB = *(LAS f32x4*)(sp + 8196);
            const float vi = cur[10240 + s * 64 + irow];
            float sa = S[0] * kA[0] + S[1] * kA[1] + S[2] * kA[2] + S[3] * kA[3] + S[4] * kB[0] + S[5] * kB[1] + S[6] * kB[2] + S[7] * kB[3];
            sa = sum8(sa);
#pragma unroll
            for (int j = 0; j < 4; ++j) { S[j] = S[j] * wA[j] + (vi * tA[j] - sa * qA[j]); S[4 + j] = S[4 + j] * wB[j] + (vi * tB[j] - sa * qB[j]); }
            float y = S[0] * rA[0] + S[1] * rA[1] + S[2] * rA[2] + S[3] * rA[3] + S[4] * rB[0] + S[5] * rB[1] + S[6] * rB[2] + S[7] * rB[3];
            y = sum8(y);
            if (c8 == 0) ybuf[s * 64 + irow] = y;
        }
        __syncthreads();
        { const f32x4 y4 = *(LAS f32x4*)(ybuf + st * 64 + c4);
          *(u32x2*)(yout + (size_t)seq_row(b, d, blk * 32 + st) * 256 + h * 64 + c4) = (u32x2){cvt_pk_bf16(y4[0], y4[1]), cvt_pk_bf16(y4[2], y4[3])}; }
        if (blk + 1 < NKEY / 32) RW_LSTORE(nxt);
        __syncthreads();
    }
#undef RW_GLOAD
#undef RW_LSTORE
}

typedef short bf16x4 __attribute__((ext_vector_type(4)));
constexpr int RC_SLOT = 16896, RC_QT = 0, RC_GT = 2560, RC_VT = 12800, RC_NB = 14848, RC_T = 15872;
constexpr int RC_GL = RC_T;
constexpr int RC_SST = 8 * RC_SLOT;
__device__ __forceinline__ float bfu(unsigned short v) { return __uint_as_float((unsigned)v << 16); }
__device__ __forceinline__ void wave_lds_sync() { __builtin_amdgcn_fence(__ATOMIC_RELEASE, "wavefront"); __builtin_amdgcn_wave_barrier(); __builtin_amdgcn_fence(__ATOMIC_ACQUIRE, "wavefront"); }
__device__ __forceinline__ f32x4 mfma16_noovl(bf16x4 a, bf16x4 b, f32x4 c) {
    f32x4 d; asm volatile("s_nop 4\n\tv_mfma_f32_16x16x16_bf16 %0, %1, %2, %3\n\ts_nop 7\n\ts_nop 7" : "=&v"(d) : "v"(a), "v"(b), "v"(c)); return d; }
__device__ __forceinline__ void mfma16x5(f32x4& d0, f32x4& d1, f32x4& d2, f32x4& d3, f32x4& d4, bf16x4 a0, bf16x4 b0, f32x4 c0, bf16x4 a1, bf16x4 b1, f32x4 c1, bf16x4 a2, bf16x4 b2, f32x4 c2,
                                         bf16x4 a3, bf16x4 b3, f32x4 c3, bf16x4 a4, bf16x4 b4, f32x4 c4) {
    asm volatile("s_nop 7\n\tv_mfma_f32_16x16x16_bf16 %0, %5, %6, %7\n\tv_mfma_f32_16x16x16_bf16 %1, %8, %9, %10\n\tv_mfma_f32_16x16x16_bf16 %2, %11, %12, %13\n\t"
                 "v_mfma_f32_16x16x16_bf16 %3, %14, %15, %16\n\tv_mfma_f32_16x16x16_bf16 %4, %17, %18, %19\n\ts_nop 7\n\ts_nop 7"
                 : "=&v"(d0), "=&v"(d1), "=&v"(d2), "=&v"(d3), "=&v"(d4)
                 : "v"(a0), "v"(b0), "v"(c0), "v"(a1), "v"(b1), "v"(c1), "v"(a2), "v"(b2), "v"(c2), "v"(a3), "v"(b3), "v"(c3), "v"(a4), "v"(b4), "v"(c4)); }
__device__ __forceinline__ void mfma16x4(f32x4& d0, f32x4& d1, f32x4& d2, f32x4& d3, bf16x4 a0, bf16x4 b0, f32x4 c0, bf16x4 a1, bf16x4 b1, f32x4 c1, bf16x4 a2, bf16x4 b2, f32x4 c2, bf16x4 a3, bf16x4 b3, f32x4 c3) {
    asm volatile("s_nop 7\n\tv_mfma_f32_16x16x16_bf16 %0, %4, %5, %6\n\tv_mfma_f32_16x16x16_bf16 %1, %7, %8, %9\n\tv_mfma_f32_16x16x16_bf16 %2, %10, %11, %12\n\t"
                 "v_mfma_f32_16x16x16_bf16 %3, %13, %14, %15\n\ts_nop 7\n\ts_nop 7"
                 : "=&v"(d0), "=&v"(d1), "=&v"(d2), "=&v"(d3)
                 : "v"(a0), "v"(b0), "v"(c0), "v"(a1), "v"(b1), "v"(c1), "v"(a2), "v"(b2), "v"(c2), "v"(a3), "v"(b3), "v"(c3)); }
__device__ __forceinline__ void mfma16x4z(f32x4& d0, f32x4& d1, f32x4& d2, f32x4& d3, bf16x4 a0, bf16x4 b0, bf16x4 a1, bf16x4 b1, bf16x4 a2, bf16x4 b2, bf16x4 a3, bf16x4 b3) {
    asm volatile("s_nop 7\n\tv_mfma_f32_16x16x16_bf16 %0, %4, %5, 0\n\tv_mfma_f32_16x16x16_bf16 %1, %6, %7, 0\n\tv_mfma_f32_16x16x16_bf16 %2, %8, %9, 0\n\t"
                 "v_mfma_f32_16x16x16_bf16 %3, %10, %11, 0\n\ts_nop 7\n\ts_nop 7"
                 : "=&v"(d0), "=&v"(d1), "=&v"(d2), "=&v"(d3)
                 : "v"(a0), "v"(b0), "v"(a1), "v"(b1), "v"(a2), "v"(b2), "v"(a3), "v"(b3)); }
__device__ __forceinline__ void rwkv_chain_chunked(LAS unsigned char* lds, int b, int h, int d, const bf16_t* streams, const bf16_t* lora, const float* k_a, bf16_t* yout) {
    const int tid = opaque_tid(), lane = tid & 63, wv = tid >> 6, t = lane & 15, kg = lane >> 4;
    const int wvs = __builtin_amdgcn_readfirstlane(wv);
    const bf16_t* Rp = streams, *Kp = streams + (size_t)NTOK * 256, *Vp = streams + (size_t)2 * NTOK * 256, *KKp = streams + (size_t)3 * NTOK * 256;
    const bf16_t* Ep = lora + (size_t)d * NTOK * 256, *Ap = lora + (size_t)(2 + d) * NTOK * 256;
    LAS unsigned char* sl = lds + wv * RC_SLOT;
    LAS unsigned char* sst = lds + (RC_SST + (wvs & 3) * 2304);
    if (wv < 4) {
#pragma unroll
        for (int bj = 0; bj < 4; ++bj)
#pragma unroll
            for (int i = 0; i < 4; ++i) *(LAS bf16_t*)(sst + (4 * kg + i) * 144 + (16 * bj + t) * 2) = 0;
    }
    u32x4 raw[6][2];
#define RC_RAWLOAD(g_) do { int ln_ = lane; asm volatile("" : "+v"(ln_)); const int tt_ = ln_ & 15; const size_t off_ = (size_t)(seq_base(b, d, ((g_) * 8 + wvs) * 16) + (d ? -tt_ : tt_)) * 256 + h * 64 + 8 * (ln_ >> 4); \
        _Pragma("unroll") for (int ks = 0; ks < 2; ++ks) { raw[0][ks] = *(const u32x4*)(Rp + off_ + 32 * ks); raw[1][ks] = *(const u32x4*)(Kp + off_ + 32 * ks); \
            raw[3][ks] = *(const u32x4*)(KKp + off_ + 32 * ks); raw[4][ks] = *(const u32x4*)(Ep + off_ + 32 * ks); raw[5][ks] = *(const u32x4*)(Ap + off_ + 32 * ks); } } while (0)
    RC_RAWLOAD(0);
    for (int g = 0; g < NKEY / 128; ++g) {
        {
            int lane_ = lane; asm volatile("" : "+v"(lane_));
            const int lane = lane_, t = lane & 15, kg = lane >> 4;
            u32x4 pA[2], pB[2], pK[2], pR[2], pL[2], pKL[2];
            f32x4 kav[2][2];
#pragma unroll
            for (int ks = 0; ks < 2; ++ks) { kav[ks][0] = *(const f32x4*)(k_a + h * 64 + 32 * ks + 8 * kg); kav[ks][1] = *(const f32x4*)(k_a + h * 64 + 32 * ks + 8 * kg + 4); }
            const bf16x4 fI = __builtin_bit_cast(bf16x4, (u32x2){(4 * kg == t ? 0x3F80u : 0u) | (4 * kg + 1 == t ? 0x3F800000u : 0u), (4 * kg + 2 == t ? 0x3F80u : 0u) | (4 * kg + 3 == t ? 0x3F800000u : 0u)});
            u32x4 rawv[2];
            { const size_t offv_ = (size_t)(seq_base(b, d, (g * 8 + wvs) * 16) + (d ? -t : t)) * 256 + h * 64 + 8 * kg; rawv[0] = *(const u32x4*)(Vp + offv_); rawv[1] = *(const u32x4*)(Vp + offv_ + 32); }
            LAS unsigned char* glw = sl + ((t == 15) ? RC_GL : RC_NB);
#pragma unroll
            for (int ks = 0; ks < 2; ++ks) {
                float xr[8], xk[8], xkk[8], xe[8], xa[8];
                unpack8(raw[0][ks], xr); unpack8(raw[1][ks], xk); unpack8(raw[3][ks], xkk); unpack8(raw[4][ks], xe); unpack8(raw[5][ks], xa);
                float vA[8], vB[8], vK[8], vL[8], vR[8], vKL[8];
#pragma unroll
                for (int j = 0; j < 8; ++j) {
                    float lg = -xe[j];
                    { float y; y = dpp<0x111>(lg); lg += y; y = dpp<0x112>(lg); lg += y; y = dpp<0x114>(lg); lg += y; y = dpp<0x118>(lg); lg += y; }
                    const float gt = __expf(lg), gi = __expf(-lg);
                    const float gtL = __shfl(gt, (lane & 48) | 15), gsh = dpp<0x111>(gt);
                    const float gp = (t == 0) ? 1.0f : gsh, gl = gtL * gi;
                    const float kka = xkk[j] * xa[j], kt = xk[j] * (1.0f + (xa[j] - 1.0f) * kav[ks][j >> 2][j & 3]);
                    vA[j] = -gp * xkk[j]; vB[j] = kka * gi; vK[j] = kt * gi; vR[j] = gt * xr[j];
                    vL[j] = kka * gl; vKL[j] = kt * gl;
                    *(LAS float*)(glw + (32 * ks + 8 * kg + j) * 4) = gt;
                }
                pA[ks] = pack8f(vA); pB[ks] = pack8f(vB); pK[ks] = pack8f(vK); pR[ks] = pack8f(vR); pL[ks] = pack8f(vL); pKL[ks] = pack8f(vKL);
            }
#define RC_F4R(p, beta) __builtin_bit_cast(bf16x4, (u32x2){p[(beta) >> 1][2 * ((beta) & 1)], p[(beta) >> 1][2 * ((beta) & 1) + 1]})
            f32x4 aT[4], lT[4];
            { f32x4 vT[4];
              mfma16x4z(vT[0], vT[1], vT[2], vT[3], RC_F4R(rawv, 0), fI, RC_F4R(rawv, 1), fI, RC_F4R(rawv, 2), fI, RC_F4R(rawv, 3), fI);
              mfma16x4z(aT[0], aT[1], aT[2], aT[3], RC_F4R(pA, 0), fI, RC_F4R(pA, 1), fI, RC_F4R(pA, 2), fI, RC_F4R(pA, 3), fI);
              mfma16x4z(lT[0], lT[1], lT[2], lT[3], RC_F4R(pL, 0), fI, RC_F4R(pL, 1), fI, RC_F4R(pL, 2), fI, RC_F4R(pL, 3), fI);
#pragma unroll
              for (int be = 0; be < 4; ++be) { const int nt = 32 * (be >> 1) + 8 * (t >> 2) + 4 * (be & 1) + (t & 3);
                  *(LAS u32x2*)(sl + RC_VT + nt * 32 + (4 * kg) * 2) = (u32x2){cvt_pk_bf16(vT[be][0], vT[be][1]), cvt_pk_bf16(vT[be][2], vT[be][3])}; } }
#undef RC_F4R
#define RC_F8(p) __builtin_bit_cast(bf16x8, p)
#define RC_F4(p, beta) __builtin_bit_cast(bf16x4, (u32x2){p[(beta) >> 1][2 * ((beta) & 1)], p[(beta) >> 1][2 * ((beta) & 1) + 1]})
#define RC_C4(x) __builtin_bit_cast(bf16x4, (u32x2){cvt_pk_bf16(x[0], x[1]), cvt_pk_bf16(x[2], x[3])})
#define RC_M16(a_, b_, c_) mfma16_noovl(a_, b_, c_)
            const f32x4 z4 = (f32x4){0.f, 0.f, 0.f, 0.f};
            f32x4 Nb = __builtin_amdgcn_mfma_f32_16x16x32_bf16(RC_F8(pB[0]), RC_F8(pA[0]), z4, 0, 0, 0); Nb = __builtin_amdgcn_mfma_f32_16x16x32_bf16(RC_F8(pB[1]), RC_F8(pA[1]), Nb, 0, 0, 0);
            f32x4 NkT = __builtin_amdgcn_mfma_f32_16x16x32_bf16(RC_F8(pA[0]), RC_F8(pK[0]), z4, 0, 0, 0); NkT = __builtin_amdgcn_mfma_f32_16x16x32_bf16(RC_F8(pA[1]), RC_F8(pK[1]), NkT, 0, 0, 0);
            f32x4 Mb = __builtin_amdgcn_mfma_f32_16x16x32_bf16(RC_F8(pB[0]), RC_F8(pR[0]), z4, 0, 0, 0); Mb = __builtin_amdgcn_mfma_f32_16x16x32_bf16(RC_F8(pB[1]), RC_F8(pR[1]), Mb, 0, 0, 0);
            f32x4 Mk = __builtin_amdgcn_mfma_f32_16x16x32_bf16(RC_F8(pK[0]), RC_F8(pR[0]), z4, 0, 0, 0); Mk = __builtin_amdgcn_mfma_f32_16x16x32_bf16(RC_F8(pK[1]), RC_F8(pR[1]), Mk, 0, 0, 0);
#pragma unroll
            for (int i = 0; i < 4; ++i) { const int s = 4 * kg + i;
                if (!(s < t)) Nb[i] = 0.f; if (!(t < s)) NkT[i] = 0.f; if (!(s <= t)) { Mb[i] = 0.f; Mk[i] = 0.f; }
                *(LAS float*)(sl + RC_NB + (s * 16 + t) * 4) = Nb[i]; }
            wave_lds_sync();
            float Tc[16];
#pragma unroll
            for (int rr = 15; rr >= 0; --rr) { float acc = (rr == t) ? 1.0f : 0.0f;
#pragma unroll
                for (int q = 3; q >= 0; --q) if (4 * q + 3 > rr) { const f32x4 nb = *(LAS f32x4*)(sl + RC_NB + (rr * 16 + 4 * q) * 4);
#pragma unroll
                    for (int e = 3; e >= 0; --e) if (4 * q + e > rr) acc += nb[e] * Tc[4 * q + e]; }
                Tc[rr] = acc; }
            f32x4 Tsel;
#pragma unroll
            for (int j = 0; j < 4; ++j) Tsel[j] = kg == 0 ? Tc[j] : kg == 1 ? Tc[4 + j] : kg == 2 ? Tc[8 + j] : Tc[12 + j];
            const bf16x4 fTT = RC_C4(Tsel);
            const bf16x4 fNk = RC_C4(NkT), fMb = RC_C4(Mb);
            bf16x4 fP[4], fLT[4], fW1;
            { bf16x4 fAT[4];
#pragma unroll
              for (int be = 0; be < 4; ++be) { fAT[be] = RC_C4(aT[be]); fLT[be] = RC_C4(lT[be]); }
              f32x4 W1T, pT[4];
              mfma16x5(W1T, pT[0], pT[1], pT[2], pT[3], fTT, fNk, z4, fTT, fAT[0], z4, fTT, fAT[1], z4, fTT, fAT[2], z4, fTT, fAT[3], z4);
              fW1 = RC_C4(W1T);
#pragma unroll
              for (int be = 0; be < 4; ++be) fP[be] = RC_C4(pT[be]); }
            float gln[4];
            { f32x4 Q2, q1[4], g2[4];
#define RC_U4(p, be) ((f32x4){bflo(p[(be) >> 1][2 * ((be) & 1)]), bfhi(p[(be) >> 1][2 * ((be) & 1)]), bflo(p[(be) >> 1][2 * ((be) & 1) + 1]), bfhi(p[(be) >> 1][2 * ((be) & 1) + 1])})
              mfma16x5(Q2, q1[0], q1[1], q1[2], q1[3], fW1, fMb, Mk, fP[0], fMb, RC_U4(pR, 0), fP[1], fMb, RC_U4(pR, 1), fP[2], fMb, RC_U4(pR, 2), fP[3], fMb, RC_U4(pR, 3));
              mfma16x4(g2[0], g2[1], g2[2], g2[3], fLT[0], fW1, RC_U4(pKL, 0), fLT[1], fW1, RC_U4(pKL, 1), fLT[2], fW1, RC_U4(pKL, 2), fLT[3], fW1, RC_U4(pKL, 3));
#undef RC_U4
              *(LAS u32x2*)(sl + RC_QT + t * 160 + (64 + 4 * kg) * 2) = (u32x2){cvt_pk_bf16(Q2[0], Q2[1]), cvt_pk_bf16(Q2[2], Q2[3])};
#pragma unroll
              for (int be = 0; be < 4; ++be) { const int ks = be >> 1, jh = be & 1, nt = 32 * ks + 8 * (t >> 2) + 4 * jh + (t & 3), n0 = 32 * ks + 8 * kg + 4 * jh;
                  gln[be] = *(LAS float*)(sl + RC_GL + nt * 4);
                  *(LAS u32x2*)(sl + RC_QT + t * 160 + n0 * 2) = (u32x2){cvt_pk_bf16(q1[be][0], q1[be][1]), cvt_pk_bf16(q1[be][2], q1[be][3])};
#pragma unroll
                  for (int i = 0; i < 4; ++i) *(LAS bf16_t*)(sl + RC_GT + (n0 + i) * 160 + (64 + t) * 2) = f2bf(g2[be][i]); } }
#pragma unroll
            for (int bj = 0; bj < 4; ++bj) { const int ntj = 32 * (bj >> 1) + 8 * (t >> 2) + 4 * (bj & 1) + (t & 3);
                f32x4 g1[4];
                mfma16x4z(g1[0], g1[1], g1[2], g1[3], fP[0], fLT[bj], fP[1], fLT[bj], fP[2], fLT[bj], fP[3], fLT[bj]);
#pragma unroll
                for (int bi = 0; bi < 4; ++bi) {
                    if (bi == bj) {
#pragma unroll
                        for (int i = 0; i < 4; ++i) g1[bi][i] += (4 * kg + i == t) ? gln[bj] : 0.f; }
                    *(LAS u32x2*)(sl + RC_GT + ntj * 160 + (32 * (bi >> 1) + 8 * kg + 4 * (bi & 1)) * 2) = (u32x2){cvt_pk_bf16(g1[bi][0], g1[bi][1]), cvt_pk_bf16(g1[bi][2], g1[bi][3])}; } }
#undef RC_F8
#undef RC_F4
#undef RC_C4
#undef RC_M16
        }
        __builtin_amdgcn_sched_barrier(0);
        if (g + 1 < NKEY / 128) RC_RAWLOAD(g + 1);
        __syncthreads();
        if (wv < 4) {
            int lane0_ = lane; asm volatile("" : "+v"(lane0_));
            bf16x8 Sa0 = *(LAS bf16x8*)(sst + (lane0_ & 15) * 144 + (8 * (lane0_ >> 4)) * 2), Sa1 = *(LAS bf16x8*)(sst + (lane0_ & 15) * 144 + (32 + 8 * (lane0_ >> 4)) * 2);
            {
                int lane_ = lane; asm volatile("" : "+v"(lane_));
                const int t = lane_ & 15, kg = lane_ >> 4;
                bf16x8 Bq[2][2], Bg[2][4][2]; bf16x4 Bq2[2], Bva[2], Bg2[2][4];
#define RA_LOADB(j8_, N) do { LAS unsigned char* cs_ = lds + (j8_) * RC_SLOT; \
                Bq[N][0] = *(LAS bf16x8*)(cs_ + RC_QT + t * 160 + (8 * kg) * 2); Bq[N][1] = *(LAS bf16x8*)(cs_ + RC_QT + t * 160 + (32 + 8 * kg) * 2); \
                Bq2[N] = *(LAS bf16x4*)(cs_ + RC_QT + t * 160 + (64 + 4 * kg) * 2); Bva[N] = *(LAS bf16x4*)(cs_ + RC_VT + (16 * wv + t) * 32 + (4 * kg) * 2); \
                _Pragma("unroll") for (int be = 0; be < 4; ++be) { LAS unsigned char* gp_ = cs_ + RC_GT + (32 * (be >> 1) + 8 * (t >> 2) + 4 * (be & 1) + (t & 3)) * 160; \
                    Bg[N][be][0] = *(LAS bf16x8*)(gp_ + (8 * kg) * 2); Bg[N][be][1] = *(LAS bf16x8*)(gp_ + (32 + 8 * kg) * 2); Bg2[N][be] = *(LAS bf16x4*)(gp_ + (64 + 4 * kg) * 2); } } while (0)
#define RA_STEP(j8_, C, N) do { \
                f32x4 Y = __builtin_amdgcn_mfma_f32_16x16x32_bf16(Sa0, Bq[C][0], (f32x4){0.f, 0.f, 0.f, 0.f}, 0, 0, 0); f32x4 Sn[4]; \
                _Pragma("unroll") for (int be = 0; be < 4; ++be) Sn[be] = __builtin_amdgcn_mfma_f32_16x16x32_bf16(Bg[C][be][0], Sa0, (f32x4){0.f, 0.f, 0.f, 0.f}, 0, 0, 0); \
                Y = __builtin_amdgcn_mfma_f32_16x16x32_bf16(Sa1, Bq[C][1], Y, 0, 0, 0); \
                _Pragma("unroll") for (int be = 0; be < 4; ++be) Sn[be] = __builtin_amdgcn_mfma_f32_16x16x32_bf16(Bg[C][be][1], Sa1, Sn[be], 0, 0, 0); \
                f32x4 Yf, Sf[4]; mfma16x5(Yf, Sf[0], Sf[1], Sf[2], Sf[3], Bva[C], Bq2[C], Y, Bg2[C][0], Bva[C], Sn[0], Bg2[C][1], Bva[C], Sn[1], Bg2[C][2], Bva[C], Sn[2], Bg2[C][3], Bva[C], Sn[3]); \
                RA_LOADB(((j8_) + 1) & 7, N); \
                *(u32x2*)(yout + (size_t)(seq_base(b, d, (g * 8 + (j8_)) * 16) + (d ? -t : t)) * 256 + h * 64 + 16 * wv + 4 * kg) = (u32x2){cvt_pk_bf16(Yf[0], Yf[1]), cvt_pk_bf16(Yf[2], Yf[3])}; \
                Sa0 = __builtin_bit_cast(bf16x8, (u32x4){cvt_pk_bf16(Sf[0][0], Sf[0][1]), cvt_pk_bf16(Sf[0][2], Sf[0][3]), cvt_pk_bf16(Sf[1][0], Sf[1][1]), cvt_pk_bf16(Sf[1][2], Sf[1][3])}); \
                Sa1 = __builtin_bit_cast(bf16x8, (u32x4){cvt_pk_bf16(Sf[2][0], Sf[2][1]), cvt_pk_bf16(Sf[2][2], Sf[2][3]), cvt_pk_bf16(Sf[3][0], Sf[3][1]), cvt_pk_bf16(Sf[3][2], Sf[3][3])}); } while (0)
                RA_LOADB(0, 0);
#pragma unroll 1
                for (int jj = 0; jj < 8; jj += 2) { RA_STEP(jj, 0, 1); RA_STEP(jj + 1, 1, 0); }
#undef RA_STEP
#undef RA_LOADB
            }
            { int lane1_ = lane; asm volatile("" : "+v"(lane1_));
              *(LAS bf16x8*)(sst + (lane1_ & 15) * 144 + (8 * (lane1_ >> 4)) * 2) = Sa0; *(LAS bf16x8*)(sst + (lane1_ & 15) * 144 + (32 + 8 * (lane1_ >> 4)) * 2) = Sa1; }
        }
        __syncthreads();
    }
}

__device__ __forceinline__ void s5_unit(LAS unsigned char* lds, int b, int gq, int l, const bf16_t* us5, bf16_t* ys5) {
    const int tid = opaque_tid(), lane = tid & 63, wv = tid >> 6;
    const int g = gq * 4 + (wv >> 1), d = wv & 1, pidx = (l * 2 + d) * 16 + g;
    const float* a_re = INP(10), *a_im = INP(11), *log_dt = INP(12), *b_re = INP(13), *b_im = INP(14), *c_re = INP(15), *c_im = INP(16);
    const double dt = exp((double)log_dt[pidx]);
    const int col = lane & 15, kg = lane >> 4;
    float ar, ai;
    { const double lr = a_re[pidx * 64 + lane], li = a_im[pidx * 64 + lane]; const double mag = exp(lr * dt); double s, c; sincos_d(li * dt, s, c); ar = (float)(mag * c); ai = (float)(mag * s); }
    bf16x8 Bf[8];
#pragma unroll
    for (int q = 0; q < 4; ++q) {
        const int n = 16 * q + col;
        const double lr = a_re[pidx * 64 + n], li = a_im[pidx * 64 + n]; const double mag = exp(lr * dt); double s, c; sincos_d(li * dt, s, c);
        const double abr = mag * c, abi = mag * s, den = lr * lr + li * li, nr = abr - 1.0;
        const float zr = (float)((nr * lr + abi * li) / den), zi = (float)((abi * lr - nr * li) / den);
        float bre[8], bim[8];
#pragma unroll
        for (int j = 0; j < 8; ++j) { const int c_ = (kg & 1) * 8 + j; const float x = b_re[((size_t)pidx * 64 + n) * 16 + c_], y = b_im[((size_t)pidx * 64 + n) * 16 + c_];
            bre[j] = kg < 2 ? zr * x - zi * y : 0.f; bim[j] = kg < 2 ? zr * y + zi * x : 0.f; }
        u32x4 w0 = (u32x4){cvt_pk_bf16(bre[0], bre[1]), cvt_pk_bf16(bre[2], bre[3]), cvt_pk_bf16(bre[4], bre[5]), cvt_pk_bf16(bre[6], bre[7])};
        u32x4 w1 = (u32x4){cvt_pk_bf16(bim[0], bim[1]), cvt_pk_bf16(bim[2], bim[3]), cvt_pk_bf16(bim[4], bim[5]), cvt_pk_bf16(bim[6], bim[7])};
        Bf[q] = __builtin_bit_cast(bf16x8, w0); Bf[4 + q] = __builtin_bit_cast(bf16x8, w1);
    }
    bf16x8 Cf[4];
#pragma unroll
    for (int ks = 0; ks < 4; ++ks) { float cv[8];
#pragma unroll
        for (int j = 0; j < 8; ++j) { const int comp = 32 * ks + 8 * kg + j, n = comp & 63; cv[j] = (comp < 64) ? c_re[((size_t)pidx * 16 + col) * 64 + n] : -c_im[((size_t)pidx * 16 + col) * 64 + n]; }
        u32x4 w = (u32x4){cvt_pk_bf16(cv[0], cv[1]), cvt_pk_bf16(cv[2], cv[3]), cvt_pk_bf16(cv[4], cv[5]), cvt_pk_bf16(cv[6], cv[7])}; Cf[ks] = __builtin_bit_cast(bf16x8, w); }
#ifdef DBG_NAN
    { unsigned* ctl_ = (unsigned*)(WSB() + WS_CTL) + (l ? 64 : 0); bool bad = !(fabsf(ar) < 1.5f) || !(fabsf(ai) < 1.5f);
      if (bad) ctl_[CW_DBG + 41] = 1u;
      bool badb = false;
#pragma unroll
      for (int q = 0; q < 8; ++q) { const u32x4 w = __builtin_bit_cast(u32x4, Bf[q]);
#pragma unroll
          for (int e = 0; e < 4; ++e) badb |= ((w[e] & 0x7f80u) == 0x7f80u) | ((w[e] & 0x7f800000u) == 0x7f800000u); }
      if (badb) ctl_[CW_DBG + 42] = 1u;
      if (!(dt > 0.0 && dt < 1.0)) ctl_[CW_DBG + 40] = 1u; }
#endif
    LAS float* BUs = (LAS float*)(lds + wv * 12544);
    LAS bf16_t* Hs = (LAS bf16_t*)(lds + wv * 12544 + 8192);
    float hre = 0.f, him = 0.f;
    const bf16x8 zero8 = (bf16x8){0, 0, 0, 0, 0, 0, 0, 0};
    bf16x8 uf0, uf1, uf2, uf3;
#define S5_ULOAD(blk) ((kg < 2) ? *(const bf16x8*)(us5 + (size_t)seq_row(b, d, (blk) * 16 + col) * 256 + g * 16 + 8 * kg) : zero8)
    uf0 = S5_ULOAD(0); uf1 = S5_ULOAD(1); uf2 = S5_ULOAD(2); uf3 = S5_ULOAD(3);
    bf16_t* yd = ys5 + (size_t)d * NTOK * 256 + g * 16 + col;
    unsigned* dbgp = (unsigned*)(WSB() + WS_CTL) + (l ? 64 : 0);
#define S5_BLOCK(blk, UF) do { \
        const bf16x8 ucur = UF; if ((blk) + 4 < NKEY / 16) UF = S5_ULOAD((blk) + 4); \
        _Pragma("unroll") for (int cb = 0; cb < 8; ++cb) { const f32x4 bu = __builtin_amdgcn_mfma_f32_16x16x32_bf16(ucur, Bf[cb], (f32x4){0.f, 0.f, 0.f, 0.f}, 0, 0, 0); \
            _Pragma("unroll") for (int i = 0; i < 4; ++i) { BUs[(4 * kg + i) * 128 + 16 * cb + col] = bu[i]; } } \
        __builtin_amdgcn_fence(__ATOMIC_RELEASE, "wavefront"); __builtin_amdgcn_wave_barrier(); __builtin_amdgcn_fence(__ATOMIC_ACQUIRE, "wavefront"); \
        { float xr_[16], xi_[16]; bf16_t hr_[16], hi_[16]; \
          _Pragma("unroll") for (int tt = 0; tt < 16; ++tt) { xr_[tt] = BUs[tt * 128 + lane]; xi_[tt] = BUs[tt * 128 + 64 + lane]; } \
          _Pragma("unroll") for (int tt = 0; tt < 16; ++tt) { const float nre = ar * hre - ai * him + xr_[tt], nim = ar * him + ai * hre + xi_[tt]; hre = nre; him = nim; hr_[tt] = f2bf(hre); hi_[tt] = f2bf(him); } \
          _Pragma("unroll") for (int tt = 0; tt < 16; ++tt) { Hs[tt * 136 + lane] = hr_[tt]; Hs[tt * 136 + 64 + lane] = hi_[tt]; } } \
        __builtin_amdgcn_fence(__ATOMIC_RELEASE, "wavefront"); __builtin_amdgcn_wave_barrier(); __builtin_amdgcn_fence(__ATOMIC_ACQUIRE, "wavefront"); \
        f32x4 yac = (f32x4){0.f, 0.f, 0.f, 0.f}; \
        _Pragma("unroll") for (int ks = 0; ks < 4; ++ks) { const bf16x8 hf = *(LAS bf16x8*)(Hs + col * 136 + 32 * ks + 8 * kg); yac = __builtin_amdgcn_mfma_f32_16x16x32_bf16(hf, Cf[ks], yac, 0, 0, 0); } \
        _Pragma("unroll") for (int i = 0; i < 4; ++i) { yd[(size_t)seq_row(b, d, (blk) * 16 + 4 * kg + i) * 256] = f2bf(yac[i]); } \
        __builtin_amdgcn_fence(__ATOMIC_RELEASE, "wavefront"); __builtin_amdgcn_wave_barrier(); __builtin_amdgcn_fence(__ATOMIC_ACQUIRE, "wavefront"); \
    } while (0)
    for (int b4 = 0; b4 < NKEY / 16; b4 += 4) { S5_BLOCK(b4, uf0); S5_BLOCK(b4 + 1, uf1); S5_BLOCK(b4 + 2, uf2); S5_BLOCK(b4 + 3, uf3); }
#undef S5_BLOCK
#undef S5_ULOAD
}

constexpr int ATT_RS = 144;
constexpr int ATT_TILE = 64 * ATT_RS;
struct AttPre { u32x4 k[2], v[2]; bf16x8 q[4]; };
__device__ __forceinline__ void attn_unit(LAS unsigned char* lds, bf16_t* qkv, const bf16_t* vt, int b, int kvh, int qrow0, int nkt, bf16_t* osep, float mbound,
                                          bool havepre, AttPre& pre, int nb, int nkvh, int nqrow0, int nnkt  ) {
    const int tid = opaque_tid(), lane = tid & 63, wid = tid >> 6, q = lane & 31, h = lane >> 5;
    const int head = kvh * 2 + (wid >> 2);
    const size_t qrow = (size_t)(qrow0 + (wid & 3) * 32 + q);
    bf16x8 Qf[4];
    if (havepre) {
#pragma unroll
        for (int kk = 0; kk < 4; ++kk) Qf[kk] = pre.q[kk];
    } else {
#pragma unroll
        for (int kk = 0; kk < 4; ++kk) Qf[kk] = *(const bf16x8*)(qkv + qrow * 1024 + head * 64 + 16 * kk + 8 * h);
    }
    const int lr = tid >> 3, lp = tid & 7;
    const bf16_t* vtp = vt + ((size_t)(b * 4 + kvh) * 64 + lr) * NKEY + lp * 8;
    const bf16_t* kbase = qkv + 512 + kvh * 64 + lp * 8;
#define ATT_KROW(n) ((n) < CTX ? (size_t)(NLAT + b * CTX + (n)) : (size_t)(b * SEQ + (n) - CTX))
#define ATT_GLOAD(kt_, kr, vr) do { const int n_ = (kt_) * 64 + lr; kr = *(const u32x4*)(kbase + ATT_KROW(n_) * 1024); vr = *(const u32x4*)(vtp + (kt_) * 64); } while (0)
#define ATT_LSTORE(kt_, kr, vr) do { LAS unsigned char* b_ = lds + ((kt_) % 3) * 2 * ATT_TILE; *(LAS u32x4*)(b_ + lr * ATT_RS + lp * 16) = kr; *(LAS u32x4*)(b_ + ATT_TILE + lr * ATT_RS + lp * 16) = vr; } while (0)
#define ATT_QK(kt_, SA, SB) do { LAS unsigned char* b_ = lds + ((kt_) % 3) * 2 * ATT_TILE; \
        _Pragma("unroll") for (int j = 0; j < 16; ++j) { SA[j] = 0.f; SB[j] = 0.f; } \
        _Pragma("unroll") for (int kk = 0; kk < 4; ++kk) { \
            const bf16x8 k0 = *(LAS bf16x8*)(b_ + q * ATT_RS + (16 * kk + 8 * h) * 2), k1 = *(LAS bf16x8*)(b_ + (32 + q) * ATT_RS + (16 * kk + 8 * h) * 2); \
            SA = __builtin_amdgcn_mfma_f32_32x32x16_bf16(k0, Qf[kk], SA, 0, 0, 0); SB = __builtin_amdgcn_mfma_f32_32x32x16_bf16(k1, Qf[kk], SB, 0, 0, 0); } } while (0)
    u32x4 kreg, vreg;
    if (havepre) { ATT_LSTORE(0, pre.k[0], pre.v[0]); if (1 < nkt) ATT_LSTORE(1, pre.k[1], pre.v[1]); }
    else { ATT_GLOAD(0, kreg, vreg); ATT_LSTORE(0, kreg, vreg);
           if (1 < nkt) { ATT_GLOAD(1, kreg, vreg); ATT_LSTORE(1, kreg, vreg); } }
    if (2 < nkt) ATT_GLOAD(2, kreg, vreg);
    __syncthreads();
    f32x16 O0, O1, S0, S1, T0, T1;
#pragma unroll
    for (int j = 0; j < 16; ++j) { O0[j] = 0.f; O1[j] = 0.f; }
    f32x16 Ls;
#pragma unroll
    for (int j = 0; j < 16; ++j) Ls[j] = 0.f;
    const bf16x8 ones8 = (bf16x8){0x3F80, 0x3F80, 0x3F80, 0x3F80, 0x3F80, 0x3F80, 0x3F80, 0x3F80};
    ATT_QK(0, S0, S1);
#define ATT_SOFTMAX_PV(kt_) \
        LAS unsigned char* buf = lds + ((kt_) % 3) * 2 * ATT_TILE; \
        _Pragma("unroll") for (int j = 0; j < 16; ++j) { S0[j] = __builtin_amdgcn_exp2f(S0[j] - mbound); S1[j] = __builtin_amdgcn_exp2f(S1[j] - mbound); } \
        bf16x8 pf[4]; \
        { u32x4 w; \
          w = (u32x4){cvt_pk_bf16(S0[0], S0[1]), cvt_pk_bf16(S0[2], S0[3]), cvt_pk_bf16(S0[4], S0[5]), cvt_pk_bf16(S0[6], S0[7])}; pf[0] = __builtin_bit_cast(bf16x8, w); \
          w = (u32x4){cvt_pk_bf16(S0[8], S0[9]), cvt_pk_bf16(S0[10], S0[11]), cvt_pk_bf16(S0[12], S0[13]), cvt_pk_bf16(S0[14], S0[15])}; pf[1] = __builtin_bit_cast(bf16x8, w); \
          w = (u32x4){cvt_pk_bf16(S1[0], S1[1]), cvt_pk_bf16(S1[2], S1[3]), cvt_pk_bf16(S1[4], S1[5]), cvt_pk_bf16(S1[6], S1[7])}; pf[2] = __builtin_bit_cast(bf16x8, w); \
          w = (u32x4){cvt_pk_bf16(S1[8], S1[9]), cvt_pk_bf16(S1[10], S1[11]), cvt_pk_bf16(S1[12], S1[13]), cvt_pk_bf16(S1[14], S1[15])}; pf[3] = __builtin_bit_cast(bf16x8, w); } \
        _Pragma("unroll") for (int g4 = 0; g4 < 4; ++g4) { \
            const bf16x8 v0 = *(LAS bf16x8*)(buf + ATT_TILE + q * ATT_RS + (16 * g4 + 8 * h) * 2), v1 = *(LAS bf16x8*)(buf + ATT_TILE + (32 + q) * ATT_RS + (16 * g4 + 8 * h) * 2); \
            O0 = __builtin_amdgcn_mfma_f32_32x32x16_bf16(v0, pf[g4], O0, 0, 0, 0); O1 = __builtin_amdgcn_mfma_f32_32x32x16_bf16(v1, pf[g4], O1, 0, 0, 0); \
            Ls = __builtin_amdgcn_mfma_f32_32x32x16_bf16(ones8, pf[g4], Ls, 0, 0, 0); }
    if (wid < 4) {
        for (int kt = 0; kt < nkt; ++kt) {
            if (kt + 1 < nkt) ATT_QK(kt + 1, T0, T1);
            ATT_SOFTMAX_PV(kt)
            if (kt + 2 < nkt) ATT_LSTORE(kt + 2, kreg, vreg);
            if (kt + 3 < nkt) ATT_GLOAD(kt + 3, kreg, vreg);
            __syncthreads();
#pragma unroll
            for (int j = 0; j < 16; ++j) { S0[j] = T0[j]; S1[j] = T1[j]; }
        }
    } else {
        for (int kt = 0; kt < nkt; ++kt) {
            { ATT_SOFTMAX_PV(kt) }
            __builtin_amdgcn_sched_barrier(0);
            if (kt + 1 < nkt) ATT_QK(kt + 1, S0, S1);
            if (kt + 2 < nkt) ATT_LSTORE(kt + 2, kreg, vreg);
            if (kt + 3 < nkt) ATT_GLOAD(kt + 3, kreg, vreg);
            __syncthreads();
        }
    }
#undef ATT_SOFTMAX_PV
#undef ATT_KROW
#undef ATT_GLOAD
#undef ATT_LSTORE
#undef ATT_QK
    if (nnkt > 0) {
        const int nhead = nkvh * 2 + (wid >> 2); const size_t nqrow = (size_t)(nqrow0 + (wid & 3) * 32 + q);
#pragma unroll
        for (int kk = 0; kk < 4; ++kk) pre.q[kk] = *(const bf16x8*)(qkv + nqrow * 1024 + nhead * 64 + 16 * kk + 8 * h);
        const bf16_t* nvtp = vt + ((size_t)(nb * 4 + nkvh) * 64 + lr) * NKEY + lp * 8; const bf16_t* nkbase = qkv + 512 + nkvh * 64 + lp * 8;
#pragma unroll
        for (int k2 = 0; k2 < 2; ++k2) if (k2 < nnkt) { const int n_ = k2 * 64 + lr; const size_t kr_ = n_ < CTX ? (size_t)(NLAT + nb * CTX + n_) : (size_t)(nb * SEQ + n_ - CTX);
            pre.k[k2] = *(const u32x4*)(nkbase + kr_ * 1024); pre.v[k2] = *(const u32x4*)(nvtp + k2 * 64); }
    }
    const float inv = 1.0f / Ls[0];
    bf16_t* op = osep ? osep + qrow * 256 + (head & 3) * 64 + 4 * h : qkv + qrow * 1024 + head * 64 + 4 * h;
#pragma unroll
    for (int rg = 0; rg < 4; ++rg) {
        *(u32x2*)(op + 8 * rg) = (u32x2){cvt_pk_bf16(O0[4 * rg] * inv, O0[4 * rg + 1] * inv), cvt_pk_bf16(O0[4 * rg + 2] * inv, O0[4 * rg + 3] * inv)};
        *(u32x2*)(op + 32 + 8 * rg) = (u32x2){cvt_pk_bf16(O1[4 * rg] * inv, O1[4 * rg + 1] * inv), cvt_pk_bf16(O1[4 * rg + 2] * inv, O1[4 * rg + 3] * inv)};
    }
}

__device__ __forceinline__ void phase_mixers(LAS unsigned char* lds, int l, bool last, unsigned char* big, unsigned* qhead) {
    bf16_t* qkv = (bf16_t*)(big + BG_QKV); const bf16_t* vt = (const bf16_t*)(big + BG_VT);
    const bf16_t* streams = (const bf16_t*)(big + BG_STR); const bf16_t* lora = (const bf16_t*)(big + BG_URW);
    const bf16_t* us5 = (const bf16_t*)(big + BG_US5); bf16_t* ys5 = (bf16_t*)(big + BG_YS5); bf16_t* yrw = (bf16_t*)(big + BG_YRW);
#ifndef REP_RWKV
#define REP_RWKV 1
#endif
#ifndef REP_S5
#define REP_S5 1
#endif
#ifndef REP_ATT
#define REP_ATT 1
#endif
#ifndef DBG_ATT_ONLY
    const float* ka_l = INP(26) + l * 256;
    for (int rep = 0; rep < REP_RWKV; ++rep)
    for (int u = blockIdx.x; u < NB * 8; u += gridDim.x) { const int b = u >> 3, h = (u >> 1) & 3, d = u & 1;
#ifdef RWKV_DIRECT
        rwkv_chain(lds, b, h, d, streams, lora, INP(26) + l * 256, yrw + (size_t)d * NTOK * 256);
#else
        rwkv_chain_chunked(lds, b, h, d, streams, lora, ka_l, yrw + (size_t)d * NTOK * 256);
#endif
    }
    __syncthreads();
    for (int rep = 0; rep < REP_S5; ++rep)
    for (int u = blockIdx.x; u < NB * 4; u += gridDim.x) s5_unit(lds, u >> 2, u & 3, l, us5, ys5);
    __syncthreads();
#endif
    float mbound;
    { const float* qg = INP(8) + l * 64, *kg_ = INP(9) + l * 64; float mq = 0.f, mk = 0.f;
      for (int i = 0; i < 64; ++i) { mq = fmaxf(mq, fabsf(qg[i])); mk = fmaxf(mk, fabsf(kg_[i])); }
      mbound = __uint_as_float(__builtin_amdgcn_readfirstlane(__float_as_uint(8.0f * mq * mk * LOG2E * 1.001f))); }
#pragma unroll
    for (int rep = 0; rep < REP_ATT; ++rep) {
        bf16_t* osep = rep + 1 < REP_ATT ? (bf16_t*)(big + BG_OS5) : nullptr;
        const int c = blockIdx.x;
        if (gridDim.x == 256) {
            const int n_u = c < 128 ? 6 : 10, u0 = c < 128 ? c * 6 : 768 + (c - 128) * 10;
            const int n_c = (!last && c >= 128) ? 2 : 0; AttPre pre; bool havepre = false;
#define ATT_DESC(j_, B_, K_, Q_, N_) do { if ((j_) < n_u) { const int u_ = u0 + (j_); B_ = u_ >> 6; K_ = (u_ >> 4) & 3; Q_ = B_ * SEQ + (u_ & 15) * 128; N_ = NKEY / 64; } \
                else if ((j_) < n_u + n_c) { const int v_ = (c - 128) * 2 + ((j_) - n_u); B_ = v_ >> 3; K_ = (v_ >> 1) & 3; Q_ = NLAT + B_ * CTX + (v_ & 1) * 128; N_ = CTX / 64; } else { B_ = 0; K_ = 0; Q_ = 0; N_ = 0; } } while (0)
            for (int j = 0; j < n_u + n_c; ++j) { int b_, k_, q_, n_, nb_, nk_, nq_, nn_; ATT_DESC(j, b_, k_, q_, n_); ATT_DESC(j + 1, nb_, nk_, nq_, nn_);
                if (osep) nn_ = 0;
                attn_unit(lds, qkv, vt, b_, k_, q_, n_, osep, mbound, havepre, pre, nb_, nk_, nq_, nn_); havepre = nn_ > 0; __syncthreads(); }
#undef ATT_DESC
        } else {
            for (int u = c; u < 2048 + (last ? 0 : 256); u += gridDim.x) {
                if (u < 2048) { const int b = u >> 6, kvh = (u >> 4) & 3, qb = u & 15; { AttPre pre_; attn_unit(lds, qkv, vt, b, kvh, b * SEQ + qb * 128, NKEY / 64, osep, mbound, false, pre_, 0, 0, 0, 0); } }
                else { const int v = u - 2048, b = v >> 3, kvh = (v >> 1) & 3, cb = v & 1; { AttPre pre_; attn_unit(lds, qkv, vt, b, kvh, NLAT + b * CTX + cb * 128, CTX / 64, osep, mbound, false, pre_, 0, 0, 0, 0); } }
                __syncthreads();
            }
        }
    }
}

__device__ __forceinline__ float gelu_tanh(float x) { const float u = 0.7978845608028654f * (x + 0.044715f * x * x * x); const float e2 = __expf(-2.0f * fabsf(u)); float th = (1.0f - e2) * __builtin_amdgcn_rcpf(1.0f + e2); th = u < 0.f ? -th : th; return 0.5f * x * (1.0f + th); }
__device__ __forceinline__ void phase_finish(LAS unsigned char* lds, int l, int nrows, unsigned char* big) {
    const bf16_t* us5 = (const bf16_t*)(big + BG_US5); const bf16_t* ys5 = (const bf16_t*)(big + BG_YS5); bf16_t* yg = (bf16_t*)(big + BG_OS5);
    const float* dskip = INP(17) + l * 256;
    const int tid_ = opaque_tid();
    for (size_t idx = (size_t)blockIdx.x * 512 + tid_; idx < (size_t)nrows * 32; idx += (size_t)gridDim.x * 512) {
        const size_t off = idx * 8; const int c = (int)(off & 255);
        float s[8], y0[8], y1[8];
        unpack8(*(const u32x4*)(us5 + off), s); unpack8(*(const u32x4*)(ys5 + off), y0); unpack8(*(const u32x4*)(ys5 + (size_t)NTOK * 256 + off), y1);
#pragma unroll
        for (int i = 0; i < 8; ++i) s[i] = gelu_tanh(y0[i] + y1[i] + dskip[c + i] * s[i]);
        *(u32x4*)(yg + off) = pack8f(s);
    }
    const bf16_t* streams = (const bf16_t*)(big + BG_STR); const bf16_t* lora = (const bf16_t*)(big + BG_URW); const bf16_t* yrw = (const bf16_t*)(big + BG_YRW); bf16_t* orw = (bf16_t*)(big + BG_QKV) + 768;
    const float* k_a = INP(26) + l * 256, *r_k = INP(27) + l * 256, *ln_w = INP(28) + l * 256, *ln_b = INP(29) + l * 256;
    const int lane = tid_ & 63, wid = tid_ >> 6;
    for (int rp = blockIdx.x * 8 + wid; rp < nrows / 2; rp += gridDim.x * 8) {
        const size_t row = (size_t)rp * 2 + (lane >> 5); const int c = (lane & 31) * 8; const size_t off = row * 256 + c;
        float y0[8], y1[8], r[8], k[8], v[8], a0[8], a1[8], g[8];
        unpack8(*(const u32x4*)(yrw + off), y0); unpack8(*(const u32x4*)(yrw + (size_t)NTOK * 256 + off), y1);
        unpack8(*(const u32x4*)(streams + off), r); unpack8(*(const u32x4*)(streams + (size_t)NTOK * 256 + off), k); unpack8(*(const u32x4*)(streams + (size_t)2 * NTOK * 256 + off), v);
        unpack8(*(const u32x4*)(lora + (size_t)2 * NTOK * 256 + off), a0); unpack8(*(const u32x4*)(lora + (size_t)3 * NTOK * 256 + off), a1); unpack8(*(const u32x4*)(lora + (size_t)4 * NTOK * 256 + off), g);
        float sm = 0.f;
#pragma unroll
        for (int i = 0; i < 8; ++i) { y0[i] += y1[i]; sm += y0[i]; }
        const float mu = sum8(sm) * (1.0f / 64.0f);
        float sv = 0.f;
#pragma unroll
        for (int i = 0; i < 8; ++i) { y0[i] -= mu; sv += y0[i] * y0[i]; }
        const float rstd = rsqrtf(sum8(sv) * (1.0f / 64.0f) + GN_EPS);
        float bs = 0.f;
#pragma unroll
        for (int i = 0; i < 8; ++i) bs += r[i] * k[i] * (2.0f + (a0[i] + a1[i] - 2.0f) * k_a[c + i]) * r_k[c + i];
        bs = sum8(bs);
#pragma unroll
        for (int i = 0; i < 8; ++i) y0[i] = (y0[i] * rstd * ln_w[c + i] + ln_b[c + i] + bs * v[i]) * g[i];
        *(u32x4*)(orw + row * 1024 + c) = pack8f(y0);
    }
}

__device__ __forceinline__ void phase_route(LAS unsigned char* lds, const float* logits, const float* bg, const float* be, int ntok, int* tok_e, float* tok_w, int* wgcnt, int* stok) {
    LAS int* hist = (LAS int*)lds; const int tid_ = opaque_tid();
    for (int i = blockIdx.x * 512 + tid_; i < MAXBLK * 256; i += gridDim.x * 512) stok[i] = 0;
    if (tid_ < 32) hist[tid_] = 0;
    __syncthreads();
    const int chunk = (ntok + gridDim.x - 1) / gridDim.x, t0 = blockIdx.x * chunk, t1 = min(ntok, t0 + chunk);
    for (int tok = t0 + tid_; tok < t1; tok += 512) {
        const float* lp = logits + (size_t)tok * 64;
        const f32x4 gl = *(const f32x4*)lp + *(const f32x4*)bg;
        int gs = 0; float gm = gl[0];
        if (gl[1] > gm) { gm = gl[1]; gs = 1; } if (gl[2] > gm) { gm = gl[2]; gs = 2; } if (gl[3] > gm) { gm = gl[3]; gs = 3; }
        const float gden = __expf(gl[0] - gm) + __expf(gl[1] - gm) + __expf(gl[2] - gm) + __expf(gl[3] - gm);
        const float gw = 1.0f / gden;
        const f32x4 e0 = *(const f32x4*)(lp + 4 + gs * 8) + *(const f32x4*)(be + gs * 8), e1 = *(const f32x4*)(lp + 8 + gs * 8) + *(const f32x4*)(be + gs * 8 + 4);
        const float el[8] = {e0[0], e0[1], e0[2], e0[3], e1[0], e1[1], e1[2], e1[3]};
        int i1 = 0; float m1 = el[0];
#pragma unroll
        for (int i = 1; i < 8; ++i) if (el[i] > m1) { m1 = el[i]; i1 = i; }
        int i2 = -1; float m2 = -3.0e38f;
#pragma unroll
        for (int i = 0; i < 8; ++i) if (i != i1 && el[i] > m2) { m2 = el[i]; i2 = i; }
        const float t = __expf(m2 - m1), w1 = gw / (1.0f + t), w2 = gw * t / (1.0f + t);
        const int x1 = gs * 8 + i1, x2 = gs * 8 + i2;
        tok_e[tok * 2] = x1; tok_e[tok * 2 + 1] = x2; tok_w[tok * 2] = w1; tok_w[tok * 2 + 1] = w2;
        __hip_atomic_fetch_add(hist + x1, 1, __ATOMIC_RELAXED, __HIP_MEMORY_SCOPE_WORKGROUP); __hip_atomic_fetch_add(hist + x2, 1, __ATOMIC_RELAXED, __HIP_MEMORY_SCOPE_WORKGROUP);
    }
    __syncthreads();
    if (tid_ < 32) wgcnt[blockIdx.x * 32 + tid_] = hist[tid_];
    __syncthreads();
}
__device__ __forceinline__ void phase_scatter(LAS unsigned char* lds, const int* wgcnt, const int* tok_e, const float* tok_w, int* pos, float* sgate, int* blk_e,
                                              int* stok, int ntok) {
    LAS int* psum = (LAS int*)lds;
    LAS int* tsum = psum + 512;
    LAS int* basee = psum + 1024;
    LAS int* tote = psum + 1056;
    LAS int* cur0 = psum + 1088;
    LAS int* slots = psum + 1120;
    const int tid_ = opaque_tid(), lane = tid_ & 63, wid = tid_ >> 6;
    const int G = gridDim.x, chunk = (ntok + G - 1) / G, t0 = blockIdx.x * chunk, t1 = min(ntok, t0 + chunk), npair = max(0, t1 - t0) * 2;
    { const int e = tid_ & 31, part = tid_ >> 5, per = (G + 15) >> 4; int a = 0, t = 0;
      for (int w = part * per; w < part * per + per && w < G; ++w) { const int c = wgcnt[w * 32 + e]; t += c; a += (w < (int)blockIdx.x) ? c : 0; }
      psum[part * 32 + e] = a; tsum[part * 32 + e] = t; }
    __syncthreads();
    if (tid_ < 32) { int base = 0, tot = 0;
#pragma unroll
        for (int p = 0; p < 16; ++p) { base += psum[p * 32 + tid_]; tot += tsum[p * 32 + tid_]; }
        basee[tid_] = base; tote[tid_] = tot; }
    __syncthreads();
    if (tid_ == 0) { int bs = 0;
        for (int x = 0; x < NEXP; ++x) { const int nb = (tote[x] + 255) >> 8; cur0[x] = bs * 256 + basee[x]; if (blockIdx.x == 0) for (int i = 0; i < nb; ++i) blk_e[bs + i] = x; bs += nb; }
        if (blockIdx.x == 0) blk_e[MAXBLK] = bs; }
    __syncthreads();
    {
        int ev[10];
#pragma unroll
        for (int k = 0; k < 10; ++k) { const int i = k * 64 + lane; ev[k] = i < npair ? tok_e[t0 * 2 + i] : -1; }
        int run = 0;
        const int c0 = lane < 4 ? cur0[4 * wid + lane] : 0;
#pragma unroll
        for (int k = 0; k < 10; ++k) { if (k * 64 < npair) {
            const int i = k * 64 + lane, e = ev[k]; int sl = -1;
#pragma unroll
            for (int j = 0; j < 4; ++j) { const int x = 4 * wid + j; const unsigned long long m = __ballot(e == x); const int r = __builtin_amdgcn_readlane(run, j), b0 = __builtin_amdgcn_readlane(c0, j);
                if (e == x) sl = b0 + r + __popcll(m & ((1ull << lane) - 1ull));
                if (lane == j) run += __popcll(m); }
            if (sl >= 0) slots[i] = sl; } }
        for (int c = 640; c < npair; c += 64) {
            const int i = c + lane; const int e = i < npair ? tok_e[t0 * 2 + i] : -1; int sl = -1;
#pragma unroll
            for (int j = 0; j < 4; ++j) { const int x = 4 * wid + j; const unsigned long long m = __ballot(e == x); const int r = __builtin_amdgcn_readlane(run, j), b0 = __builtin_amdgcn_readlane(c0, j);
                if (e == x) sl = b0 + r + __popcll(m & ((1ull << lane) - 1ull));
                if (lane == j) run += __popcll(m); }
            if (sl >= 0) slots[i] = sl; }
    }
    __syncthreads();
    for (int i = tid_; i < npair; i += 512) { const int lane = 0;
        const int pi = t0 * 2 + i, slot = slots[i];
        if (lane == 0) { pos[pi] = slot; sgate[slot] = tok_w[pi]; stok[slot] = pi >> 1; }
    }
    __syncthreads();
}
#define WS_(T, off) ((T*)(WSB() + (off)))
#define BIG_(T, off) ((T*)(WSB() + WS_BIG + (off)))
#define MODL(l_) (WS_(float, WS_MOD) + (size_t)(l_) * 33 * MODW)
#define WSM(l_) (WS_(bf16_t, WS_W) + (size_t)(l_) * SW_LAYER)

#ifdef DBG_NAN
__device__ __forceinline__ void dbg_scan(unsigned* ctl, const void* p, size_t bytes, int code, bool isf32) {
    const u32x4* q = (const u32x4*)p; const size_t n = bytes / 16; bool bad = false;
    const int tid_ = opaque_tid();
    for (size_t i = (size_t)blockIdx.x * 512 + tid_; i < n; i += (size_t)gridDim.x * 512) { const u32x4 w = q[i];
#pragma unroll
        for (int e = 0; e < 4; ++e) { if (isf32) bad |= ((w[e] & 0x7f800000u) == 0x7f800000u); else bad |= ((w[e] & 0x7f80u) == 0x7f80u) | ((w[e] & 0x7f800000u) == 0x7f800000u); } }
    if (bad) ctl[CW_DBG + code] = 1u;
}
#define DBG_SCAN(ptr, bytes, code, isf32) dbg_scan(WS_(unsigned, WS_CTL), (ptr), (bytes), (code), (isf32))
#else
#define DBG_SCAN(ptr, bytes, code, isf32) do {} while (0)
#endif
template <int l> __device__ __forceinline__ void layer_body(unsigned char* shm, LAS unsigned char* lds, const XcdBarrier& bar) {
    using namespace pg8;
    const int G = gridDim.x, cidx = blockIdx.x;
    constexpr int ML = (l == DEPTH - 1) ? NLAT : NTOK;
#ifndef STOP_L0
#define STOP_L0 99
#endif
#define PHL(n) (PH_ON(n) && (l == 0 ? (n) <= STOP_L0 : (n) <= STOP_L1))
        if (PHL(3)) { if (l == 0) phase_norm(INP(0), INP(2), NTOK, INP(6), MODL(0), 0, D, WS_(bf16_t, WS_H), false, nullptr, nullptr, nullptr, nullptr, nullptr);
            else phase_norm(OUTP(), WS_(float, WS_XC), NTOK, INP(6) + l * D, MODL(l), 0, D, WS_(bf16_t, WS_H), true, MODL(l - 1), WS_(int, WS_META + MT_POS), BIG_(const bf16_t, BG_XS), OUTP(), WS_(float, WS_XC)); }
        xcd_barrier(bar);
        DBG_SCAN(WS_(bf16_t, WS_H), 4 * R36, 2 + 20 * l, false);
        if (PHL(4)) { Gemm g{WS_(bf16_t, WS_H), WSM(l) + SW_IN, NTOK, NMIX, D, D}; StaticOrder S; S.init(NTOK, NMIX, G, cidx);
          EpiInproj E{BIG_(bf16_t, BG_QKV), BIG_(bf16_t, BG_US5), BIG_(bf16_t, BG_URW)}; gemm_phase(lds, g, S, E); }
        xcd_barrier(bar);
        DBG_SCAN(BIG_(bf16_t, BG_QKV), 4 * R36, 3 + 20 * l, false); DBG_SCAN(BIG_(bf16_t, BG_US5), 5 * R36, 3 + 20 * l, false);
        if (PHL(5)) phase_prep(shm, BIG_(bf16_t, BG_QKV), BIG_(bf16_t, BG_VT), BIG_(const bf16_t, BG_URW), BIG_(bf16_t, BG_STR), BIG_(bf16_t, BG_ORW),
                   INP(8) + l * 64, INP(9) + l * 64, WS_(float, WS_ROPE), INP(19) + (size_t)l * 3 * 1024, INP(25) + l * 256);
        xcd_barrier(bar);
        DBG_SCAN(BIG_(bf16_t, BG_QKV), 4 * R36, 4 + 20 * l, false); DBG_SCAN(BIG_(bf16_t, BG_VT), R36, 4 + 20 * l, false); DBG_SCAN(BIG_(bf16_t, BG_STR), 4 * R36, 4 + 20 * l, false); DBG_SCAN(BIG_(bf16_t, BG_ORW), R36, 4 + 20 * l, false);
        if (PHL(6)) { Gemm g{BIG_(const bf16_t, BG_ORW), WSM(l) + SW_LORA, NTOK, 1280, 256, 256}; StaticOrder S; S.init(NTOK, 1280, G, cidx);
          EpiLora E{BIG_(bf16_t, BG_URW), INP(20) + l * 512, INP(22) + l * 512}; gemm_phase(lds, g, S, E); }
        xcd_barrier(bar);
        DBG_SCAN(BIG_(bf16_t, BG_URW), 5 * R36, 5 + 20 * l, false);
        if (PHL(7)) phase_mixers(lds, l, l == DEPTH - 1, WSB() + WS_BIG, WS_(unsigned, WS_CTL) + CW_ATT + l * 64);
        xcd_barrier(bar);
        DBG_SCAN(BIG_(bf16_t, BG_QKV), 4 * R36, 6 + 20 * l, false); DBG_SCAN(BIG_(bf16_t, BG_YS5), 2 * R36, 7 + 20 * l, false); DBG_SCAN(BIG_(bf16_t, BG_YRW), 2 * R36, 8 + 20 * l, false);
        if (PHL(8)) phase_finish(lds, l, ML, WSB() + WS_BIG);
        xcd_barrier(bar);
        DBG_SCAN(BIG_(bf16_t, BG_US5), R36, 9 + 20 * l, false); DBG_SCAN(BIG_(bf16_t, BG_ORW), R36, 10 + 20 * l, false);
        if (PHL(9)) { Gemm g{BIG_(const bf16_t, BG_OS5), WSM(l) + SW_GLU, ML, 512, 256, 256}; StaticOrder S; S.init(ML, 512, G, cidx); EpiGlu E{BIG_(bf16_t, BG_QKV) + 512}; gemm_phase(lds, g, S, E); }
        if (PHL(10)) { Gemm g{WS_(bf16_t, WS_H), WSM(l) + SW_IN + (size_t)NMIX * D, ML, 3072, D, D}; StaticOrder S; S.init(ML, 3072, G, (cidx + (G >> 1)) % G);        EpiGates E{BIG_(bf16_t, BG_GATES)}; gemm_phase(lds, g, S, E); }
        xcd_barrier(bar);
        DBG_SCAN(BIG_(bf16_t, BG_OS5), R36, 11 + 20 * l, false); DBG_SCAN(BIG_(bf16_t, BG_GATES), 12 * R36, 12 + 20 * l, false);
        if (PHL(11)) { MergeArgs g{BIG_(const bf16_t, BG_QKV), WSM(l) + SW_PA, BIG_(const bf16_t, BG_GATES), BIG_(bf16_t, BG_MERGED), ML};
          StaticOrder S; S.init(ML, D, G, cidx); gemm_phase_merge(lds, g, S); }
        xcd_barrier(bar);
        DBG_SCAN(BIG_(bf16_t, BG_MERGED), 4 * R36, 13 + 20 * l, false);
        if (PHL(14)) { Gemm g{BIG_(const bf16_t, BG_MERGED), WSM(l) + SW_OUT, ML, D, D, D}; StaticOrder S; S.init(ML, D, G, cidx);
          EpiResid E{l == 0 ? INP(0) : OUTP(), l == 0 ? INP(2) : WS_(float, WS_XC), OUTP(), WS_(float, WS_XC), MODL(l) + 2 * D}; gemm_phase(lds, g, S, E); }
        xcd_barrier(bar);
        DBG_SCAN(OUTP(), (size_t)NLAT * D * 4, 14 + 20 * l, true); DBG_SCAN(WS_(float, WS_XC), (size_t)NCTX * D * 4, 14 + 20 * l, true);
        if (PHL(15)) phase_norm(OUTP(), WS_(float, WS_XC), ML, INP(34) + l * D, MODL(l), 3 * D, 4 * D, WS_(bf16_t, WS_H), false, nullptr, nullptr, nullptr, nullptr, nullptr);
        if (PHL(16)) phase_cvt_experts(shm, lds, l, BIG_(bf16_t, BG_WGU), BIG_(bf16_t, BG_WDN));
        xcd_barrier(bar);
        DBG_SCAN(WS_(bf16_t, WS_H), 4 * R36, 15 + 20 * l, false);
        if (PHL(17)) { Gemm g{WS_(bf16_t, WS_H), WSM(l) + SW_RT, ML, 256, D, D}; StaticOrder S; S.init(ML, 256, G, cidx); EpiLogits E{BIG_(float, BG_LOGIT)}; gemm_phase(lds, g, S, E); }
        xcd_barrier(bar);
        if (PHL(18)) phase_route(lds, BIG_(const float, BG_LOGIT), INP(36) + l * 4, INP(38) + l * 32, ML, WS_(int, WS_META + MT_TOKE), WS_(float, WS_META + MT_TOKW), WS_(int, WS_META + MT_WGCNT), WS_(int, WS_META + MT_STOK));
        xcd_barrier(bar);
        if (PHL(19)) phase_scatter(lds, WS_(const int, WS_META + MT_WGCNT), WS_(int, WS_META + MT_TOKE), WS_(float, WS_META + MT_TOKW), WS_(int, WS_META + MT_POS),
                                     WS_(float, WS_META + MT_SGATE), WS_(int, WS_META + MT_BLKE), WS_(int, WS_META + MT_STOK), ML);
        xcd_barrier(bar);
        if (PHL(20)) { const int* blk_e = WS_(int, WS_META + MT_BLKE); const int nblk = blk_e[MAXBLK]; Gemm g{WS_(const bf16_t, WS_H), BIG_(const bf16_t, BG_WGU), MAXBLK * 256, 1024, D, D}; MoeOrder S{nblk * 4, G, cidx, blk_e};
          EpiGU E{BIG_(bf16_t, BG_ACT)}; gemm_phase_gather(lds, g, WS_(const int, WS_META + MT_STOK), S, E); }
        xcd_barrier(bar);
        if (PHL(21)) { const int* blk_e = WS_(int, WS_META + MT_BLKE); const int nblk = blk_e[MAXBLK]; Gemm g{BIG_(const bf16_t, BG_ACT), BIG_(const bf16_t, BG_WDN), MAXBLK * 256, 1024, 512, 512}; MoeOrder S{nblk * 4, G, cidx, blk_e};
          EpiDown E{BIG_(bf16_t, BG_XS), WS_(float, WS_META + MT_SGATE)}; gemm_phase(lds, g, S, E); }
        xcd_barrier(bar);
    }

__global__ void __launch_bounds__(512, 2) fwd_kernel(Args a) {
    extern __shared__ __attribute__((aligned(16))) unsigned char shm[];
    LAS unsigned char* lds = (LAS unsigned char*)shm;
    if (threadIdx.x == 0) *(LAS u32x4*)(lds + LDS_BARW) = (u32x4){0u, 0u, 0u, 0u};
    if (threadIdx.x < 42) *(LAS unsigned long long*)(lds + LDS_PTR + threadIdx.x * 8) = (unsigned long long)a.in[threadIdx.x];
    if (threadIdx.x == 42) *(LAS unsigned long long*)(lds + LDS_PTR + 42 * 8) = (unsigned long long)a.out;
    if (threadIdx.x == 43) *(LAS unsigned long long*)(lds + LDS_PTR + 43 * 8) = (unsigned long long)a.ws;
    __syncthreads();
    XcdBarrier bar = xcd_barrier_post((unsigned*)(WSB() + WS_CTL) + CW_BAR, (volatile LAS unsigned*)(lds + LDS_BARW));
    const int G = gridDim.x, cidx = blockIdx.x;
    using namespace pg8;

    if (PH_ON(0)) phase_mod(shm, INP(1), INP(3), INP(4), INP(5), WS_(float, WS_MOD));
    if (PH_ON(1)) { phase_cvt_small(shm, lds, 0, WSM(0)); phase_cvt_small(shm, lds, 1, WSM(1)); }
    if (PH_ON(2)) phase_rope(WS_(float, WS_ROPE));
    xcd_barrier(bar);

    layer_body<0>(shm, lds, bar);
#ifndef DBG_L0ONLY
    layer_body<1>(shm, lds, bar);
#endif
#ifndef DBG_DUMP
    if (PH_ON(22)) phase_norm(OUTP(), WS_(float, WS_XC), NLAT, nullptr, MODL(0), 0, 0, nullptr, true, MODL(DEPTH - 1), WS_(int, WS_META + MT_POS), BIG_(const bf16_t, BG_XS), OUTP(), WS_(float, WS_XC));
#endif
#ifdef DBG_NAN
    xcd_barrier(bar);
    DBG_SCAN(WS_(float, WS_MOD), (size_t)2 * 33 * MODW * 4, 1, true);
    { unsigned* ctl = WS_(unsigned, WS_CTL); int code = 0;
      for (int c = 39; c >= 1; --c) if (ctl[CW_DBG + c]) code = c;
      for (int c = 59; c >= 40; --c) if (ctl[CW_DBG + c]) code = c;
      if (ctl[XB_TMO]) code = 60;
      float* o = OUTP();
      const int tid_ = opaque_tid();
      for (size_t i = (size_t)blockIdx.x * 512 + tid_; i < (size_t)NLAT * D; i += (size_t)gridDim.x * 512) { float v = o[i]; const bool nf = (__float_as_uint(v) & 0x7f800000u) == 0x7f800000u;
          if (code) v = 100.0f * code; else if (nf) v = 7000.0f; o[i] = v; } }
#endif
#ifdef DBG_DUMP
    xcd_barrier(bar);
    { const int tid_ = opaque_tid(); float* o = OUTP(); const bf16_t* bg = BIG_(const bf16_t, 0);
      for (size_t i = (size_t)blockIdx.x * 512 + tid_; i < (size_t)NLAT * D; i += (size_t)gridDim.x * 512) { float v = 0.f;
          { const bool sel = DUMP_SEL; v = sel ? (float)(bg[(size_t)DUMP_OFF / 2 + i] & 0xffu) : 0.f; }
          o[i] = v; } }
#endif
}

extern "C" void kernel_launch(void* const* d_in, const int* in_sizes, int n_in, void* d_out, int out_size, void* d_ws, size_t ws_size, hipStream_t stream) {
    static int grid = 0;
    if (grid == 0) {
        if (n_in != 42 || out_size != NLAT * D || ws_size < WS_END) { fprintf(stderr, "kernel_launch: unexpected shapes (n_in %d out %d ws %zu)\n", n_in, out_size, ws_size); grid = -1; return; }
        int dev = 0, cus = 0, per_cu = 0;
        if (hipGetDevice(&dev) != hipSuccess || hipDeviceGetAttribute(&cus, hipDeviceAttributeMultiprocessorCount, dev) != hipSuccess) { grid = -1; return; }
        if (hipFuncSetAttribute((const void*)fwd_kernel, hipFuncAttributeMaxDynamicSharedMemorySize, LDS_BYTES) != hipSuccess) { fprintf(stderr, "kernel_launch: hipFuncSetAttribute failed\n"); grid = -1; return; }
        if (hipOccupancyMaxActiveBlocksPerMultiprocessor(&per_cu, (const void*)fwd_kernel, 512, LDS_BYTES) != hipSuccess || per_cu < 1) { fprintf(stderr, "kernel_launch: occupancy query says %d\n", per_cu); grid = -1; return; }
        grid = cus;
    }
    if (grid < 0) return;
    (void)in_sizes;
#if defined(DBG_NAN) || defined(DBG_DUMP) || defined(WS_ZERO)
    (void)hipMemsetAsync((char*)d_ws, 0, WS_END, stream);
#else
    (void)hipMemsetAsync((char*)d_ws + WS_CTL, 0, CTL_BYTES, stream);
#endif
    Args a{};
    for (int i = 0; i < 42; ++i) a.in[i] = (const float*)d_in[i];
    a.out = (float*)d_out; a.ws = (unsigned char*)d_ws;
    hipLaunchKernelGGL(fwd_kernel, dim3(grid), dim3(512), LDS_BYTES, stream, a);
}
```

```cpp
#include <hip/hip_runtime.h>
#include <cstdio>
#include <cstdint>
#define REP_PRE 1

#define LAS __attribute__((address_space(3)))
typedef unsigned short bf16_t;
typedef short bf16x8 __attribute__((ext_vector_type(8)));
typedef float f32x4 __attribute__((ext_vector_type(4)));
typedef float f32x2 __attribute__((ext_vector_type(2)));
typedef float f32x16 __attribute__((ext_vector_type(16)));
typedef unsigned u32x4 __attribute__((ext_vector_type(4)));
typedef unsigned u32x2 __attribute__((ext_vector_type(2)));

constexpr int NB = 32, SEQ = 2048, CTX = 256, D = 1024, DEPTH = 2;
constexpr int NLAT = NB * SEQ, NCTX = NB * CTX, NTOK = NLAT + NCTX;
constexpr int NKEY = SEQ + CTX;
constexpr int INW = 5376, NMIX = 2304;
constexpr int NEXP = 32, FEXP = 512;
constexpr int MODW = 6 * D;
constexpr int MAXBLK = 608;
constexpr float EPS = 1e-6f, GN_EPS = 64e-5f;
constexpr float LOG2E = 1.4426950408889634f;

constexpr size_t MiB = 1u << 20;
constexpr size_t WS_CTL = 0;
constexpr size_t CTL_BYTES = 1 * MiB;
constexpr size_t WS_MOD = 1 * MiB;
constexpr size_t WS_ROPE = 3 * MiB;
constexpr size_t WS_META = 4 * MiB;
constexpr size_t WS_XC = 8 * MiB;
constexpr size_t WS_W = 40 * MiB;
constexpr size_t WS_H = 74 * MiB;
constexpr size_t WS_BIG = 218 * MiB;
constexpr size_t WS_END = 1024 * MiB;
constexpr int CW_BAR = 0;
constexpr int CW_CNT = 4096;
constexpr int CW_CUR = 4096 + 64;
constexpr int CW_ATT = 4096 + 128;
constexpr int CW_DBG = 8192;
constexpr size_t MT_TOKE = 0;
constexpr size_t MT_TOKW = MT_TOKE + (size_t)NTOK * 2 * 4;
constexpr size_t MT_POS = MT_TOKW + (size_t)NTOK * 2 * 4;
constexpr size_t MT_SGATE = MT_POS + (size_t)NTOK * 2 * 4;
constexpr size_t MT_BLKE = MT_SGATE + (size_t)MAXBLK * 256 * 4;
constexpr size_t MT_WGCNT = MT_BLKE + 4096;
constexpr size_t MT_STOK = MT_WGCNT + 1024 * 32 * 4;
static_assert(MT_STOK + (size_t)MAXBLK * 256 * 4 <= 4 * MiB, "meta");
constexpr size_t SW_IN = 0;
constexpr size_t SW_GLU = SW_IN + (size_t)INW * D;
constexpr size_t SW_PA = SW_GLU + 512 * 256;
constexpr size_t SW_PS = SW_PA + 1024 * 512;
constexpr size_t SW_PR = SW_PS + 1024 * 256;
constexpr size_t SW_OUT = SW_PR + 1024 * 256;
constexpr size_t SW_LORA = SW_OUT + 1024 * 1024;
constexpr size_t SW_RT = SW_LORA + 1280 * 256;
constexpr size_t SW_LAYER = SW_RT + 256 * 1024;
static_assert(SW_LAYER * 2 * 2 <= 34 * MiB, "small weights");
constexpr size_t R36 = (size_t)NTOK * 256 * 2;
constexpr size_t BG_QKV = 0;
constexpr size_t BG_ORW = BG_QKV + 4 * R36;
constexpr size_t BG_OS5 = BG_ORW + R36;
constexpr size_t BG_US5 = BG_OS5 + R36;
constexpr size_t BG_URW = BG_US5 + R36;
constexpr size_t BG_STR = BG_URW + 5 * R36;
constexpr size_t BG_YS5 = BG_STR + 4 * R36;
constexpr size_t BG_YRW = BG_YS5 + 2 * R36;
constexpr size_t BG_VT = BG_YRW + 2 * R36;
constexpr size_t BG_MIX_END = BG_VT + R36;
constexpr size_t BG_GATES = BG_US5;
constexpr size_t BG_MERGED = BG_GATES + 12 * R36;
constexpr size_t BG_GATE_END = BG_MERGED + 4 * R36;
constexpr size_t BG_WGU = 0;
constexpr size_t BG_WDN = 64 * MiB;
constexpr size_t BG_LOGIT = 96 * MiB;
constexpr size_t BG_XS = 114 * MiB;
constexpr size_t BG_ACT = BG_XS + (size_t)MAXBLK * 256 * 1024 * 2;
constexpr size_t BG_MOE_END = BG_ACT + (size_t)MAXBLK * 256 * 512 * 2;
static_assert(WS_BIG + BG_MIX_END <= WS_END && WS_BIG + BG_GATE_END <= WS_END && WS_BIG + BG_MOE_END <= WS_END, "workspace");
static_assert(BG_YS5 >= BG_GATES + 0 && BG_MERGED >= BG_YS5, "layout sanity");

constexpr int LDS_BYTES = 147456;
constexpr int LDS_BARW = LDS_BYTES - 16;

struct Args { const float* in[42]; float* out; unsigned char* ws; };
#ifndef PH_MASK
#define PH_MASK 0xFFFFFFFFu
#endif
#define PH_ON(n) (((PH_MASK) >> (n)) & 1u)
#ifndef REPMASK
#define REPMASK 0u
#endif
#ifndef STOP_L1
#define STOP_L1 99
#endif
constexpr int LDS_PTR = LDS_BYTES - 512;
__device__ __forceinline__ const float* ldptr(LAS unsigned char* lds, int i) {
    const unsigned long long v = *(volatile LAS unsigned long long*)(lds + LDS_PTR + i * 8);
    const unsigned lo = __builtin_amdgcn_readfirstlane((unsigned)v), hi = __builtin_amdgcn_readfirstlane((unsigned)(v >> 32));
    typedef __attribute__((address_space(1))) const float gfloat_t;
    return (const float*)(gfloat_t*)(((unsigned long long)hi << 32) | lo);
}
#define INP(i) ldptr(lds, (i))
#define OUTP() ((float*)ldptr(lds, 42))
#define WSB() ((unsigned char*)ldptr(lds, 43))

typedef __bf16 bf16v2_t __attribute__((ext_vector_type(2)));
__device__ __forceinline__ unsigned cvt_pk_bf16(float lo, float hi) { const f32x2 v = (f32x2){lo, hi}; const bf16v2_t b = __builtin_convertvector(v, bf16v2_t); return __builtin_bit_cast(unsigned, b); }
__device__ __forceinline__ float bflo(unsigned u) { return __uint_as_float(u << 16); }
__device__ __forceinline__ float bfhi(unsigned u) { return __uint_as_float(u & 0xffff0000u); }
__device__ __forceinline__ float bf2f(bf16_t v) { return __uint_as_float((unsigned)v << 16); }
__device__ __forceinline__ bf16_t f2bf(float f) { return (bf16_t)(cvt_pk_bf16(f, 0.f) & 0xffffu); }
__device__ __forceinline__ void unpack8(const u32x4 w, float (&x)[8]) { x[0] = bflo(w[0]); x[1] = bfhi(w[0]); x[2] = bflo(w[1]); x[3] = bfhi(w[1]); x[4] = bflo(w[2]); x[5] = bfhi(w[2]); x[6] = bflo(w[3]); x[7] = bfhi(w[3]); }
__device__ __forceinline__ u32x4 pack8f(const float (&x)[8]) { return (u32x4){cvt_pk_bf16(x[0], x[1]), cvt_pk_bf16(x[2], x[3]), cvt_pk_bf16(x[4], x[5]), cvt_pk_bf16(x[6], x[7])}; }
__device__ __forceinline__ float sigmoidf_(float x) { return __builtin_amdgcn_rcpf(1.0f + __builtin_amdgcn_exp2f(-1.4426950408889634f * x)); }
template <int CTRL> __device__ __forceinline__ float dpp(float x) { return __builtin_bit_cast(float, __builtin_amdgcn_mov_dpp(__builtin_bit_cast(int, x), CTRL, 0xf, 0xf, true)); }
__device__ __forceinline__ float sum8(float x) { x += dpp<0xB1>(x); x += dpp<0x4E>(x); x += dpp<0x141>(x); return x; }
__device__ __forceinline__ float wave_sum(float x) {
    x += dpp<0xB1>(x); x += dpp<0x4E>(x); x += dpp<0x141>(x);
    x += dpp<0x140>(x);
    x += __shfl_xor(x, 16); x += __shfl_xor(x, 32); return x;
}
__device__ __forceinline__ float swap32_max(float x) { auto rr = __builtin_amdgcn_permlane32_swap(__float_as_uint(x), __float_as_uint(x), false, false); return fmaxf(__uint_as_float(rr[0]), __uint_as_float(rr[1])); }
__device__ __forceinline__ float swap32_sum(float x) { auto rr = __builtin_amdgcn_permlane32_swap(__float_as_uint(x), __float_as_uint(x), false, false); return __uint_as_float(rr[0]) + __uint_as_float(rr[1]); }
__device__ __forceinline__ int opaque_tid() { int t = threadIdx.x; asm volatile("" : "+v"(t)); return t; }
__device__ __forceinline__ int tok_modrow(int row) { return row < NLAT ? (row >> 11) : 32; }
__device__ __forceinline__ int seq_row(int b, int d, int s) {
    if (s < CTX) { const int ci = d ? (CTX - 1 - s) : s; return NLAT + b * CTX + ci; }
    const int li0 = s - CTX, li = d ? (SEQ - 1 - li0) : li0; return b * SEQ + li;
}
__device__ __forceinline__ int seq_base(int b, int d, int s0) {
    if (s0 < CTX) return NLAT + b * CTX + (d ? (CTX - 1 - s0) : s0);
    const int li0 = s0 - CTX; return b * SEQ + (d ? (SEQ - 1 - li0) : li0);
}
__device__ __forceinline__ void sincos_d(double x, double& s, double& c) {
    const double k = rint(x * 0.6366197723675814);
    double r = fma(-k, 1.5707963267948966, x); r = fma(-k, 6.123233995736766e-17, r);
    const double r2 = r * r;
    double sp = 1.58969099521155010221e-10; sp = fma(sp, r2, -2.50507602534068634195e-08); sp = fma(sp, r2, 2.75573137070700676789e-06); sp = fma(sp, r2, -1.98412698298579493134e-04);
    sp = fma(sp, r2, 8.33333333332248946124e-03); sp = fma(sp, r2, -1.66666666666666324348e-01); const double sr = fma(sp * r2, r, r);
    double cp = -1.13596475577881948265e-11; cp = fma(cp, r2, 2.08757232129817482790e-09); cp = fma(cp, r2, -2.75573143513906633035e-07); cp = fma(cp, r2, 2.48015872894767294178e-05);
    cp = fma(cp, r2, -1.38888888888741095749e-03); cp = fma(cp, r2, 4.16666666666666019037e-02); const double cr = fma(fma(cp, r2, -0.5), r2, 1.0);
    const int q = ((int)k) & 3;
    s = (q == 0) ? sr : (q == 1) ? cr : (q == 2) ? -sr : -cr;
    c = (q == 0) ? cr : (q == 1) ? -sr : (q == 2) ? -cr : sr;
}

#define XB_TMO      128
#define XB_XCNT(j)  (256  + 64 * (j))
#define XB_XSUB(j)  (1280 + 64 * (j))
#define XB_XGEN(j)  (2304 + 64 * (j))
#define XB_TOP      3328
#define XB_TOPGEN   3392
#define XCD_BAR_WORDS 3456
#define XB_SPIN_CAP (1u << 26)
__device__ __forceinline__ unsigned xb_ld(unsigned* p)              { return __hip_atomic_load(p, __ATOMIC_RELAXED, __HIP_MEMORY_SCOPE_AGENT); }
__device__ __forceinline__ unsigned xb_add(unsigned* p, unsigned v) { return __hip_atomic_fetch_add(p, v, __ATOMIC_RELAXED, __HIP_MEMORY_SCOPE_AGENT); }
__device__ __forceinline__ unsigned xb_xcc_id() { return (unsigned)__builtin_amdgcn_s_getreg((3 << 11) | 20) & 0xFu; }
#define XB_SPIN(cond, bar) do { unsigned _sp = 0; while (cond) { __builtin_amdgcn_s_sleep(1); \
    if ((++_sp & 255u) == 0u) { if (xb_ld(&(bar)[XB_TMO])) break; if (_sp > XB_SPIN_CAP) { atomicAdd(&(bar)[XB_TMO], 1u); break; } } } } while (0)
struct XcdBarrier { unsigned* bar; unsigned x; volatile LAS unsigned* st; };
__device__ __forceinline__ XcdBarrier xcd_barrier_post(unsigned* bar, volatile LAS unsigned* st) {
    XcdBarrier b; b.bar = bar; b.x = xb_xcc_id(); b.st = st;
    if (threadIdx.x == 0) (void)xb_add(&bar[XB_XCNT(b.x)], 1u);
    return b;
}
__device__ __forceinline__ void xcd_barrier_complete(unsigned* bar, unsigned x, unsigned& nloc, unsigned& nx) {
    const unsigned G = gridDim.x * gridDim.y * gridDim.z;
    unsigned sum, cnt, mine, sp = 0u;
    for (;;) {
        sum = 0u; cnt = 0u; mine = 0u;
#pragma unroll
        for (unsigned j = 0; j < 16; ++j) { const unsigned c = xb_ld(&bar[XB_XCNT(j)]); sum += c; cnt += (c > 0u) ? 1u : 0u; mine = (j == x) ? c : mine; }
        if (sum == G) break;
        __builtin_amdgcn_s_sleep(1);
        if ((++sp & 255u) == 0u) { if (xb_ld(&bar[XB_TMO])) break; if (sp > XB_SPIN_CAP) { atomicAdd(&bar[XB_TMO], 1u); break; } }
    }
    nloc = mine > 0u ? mine : 1u; nx = cnt > 0u ? cnt : 1u;
}
#ifndef REP_BAR
#define REP_BAR 1
#endif
__device__ __forceinline__ void xcd_barrier1(const XcdBarrier& b);
__device__ __forceinline__ void xcd_barrier(const XcdBarrier& b) { for (int r = 0; r < REP_BAR; ++r) xcd_barrier1(b); }
__device__ __forceinline__ void xcd_barrier1(const XcdBarrier& b) {
#ifdef XB_STRONG
    __builtin_amdgcn_fence(__ATOMIC_SEQ_CST, "");
#endif
    asm volatile("s_waitcnt vmcnt(0)" ::: "memory");
    __syncthreads();
    if (threadIdx.x == 0) {
        unsigned* bar = b.bar;
        __builtin_amdgcn_s_waitcnt(0);
        unsigned nloc = b.st[0], nx = b.st[1];
        if (nloc == 0u) { xcd_barrier_complete(bar, b.x, nloc, nx); b.st[0] = nloc; b.st[1] = nx; }
        const unsigned old = xb_add(&bar[XB_XSUB(b.x)], 1u);
        const unsigned gen = old / nloc;
        if (old + 1u == (gen + 1u) * nloc) {
            __builtin_amdgcn_fence(__ATOMIC_RELEASE, "agent");
            asm volatile("s_waitcnt vmcnt(0)" ::: "memory");
            const unsigned og = xb_add(&bar[XB_TOP], 1u);
            const unsigned tg = og / nx;
            if (og + 1u == (tg + 1u) * nx) xb_add(&bar[XB_TOPGEN], 1u);
            else XB_SPIN(xb_ld(&bar[XB_TOPGEN]) == tg, bar);
            __builtin_amdgcn_fence(__ATOMIC_ACQUIRE, "agent");
            xb_add(&bar[XB_XGEN(b.x)], 1u);
            asm volatile("s_waitcnt vmcnt(0)" ::: "memory");
        } else {
            XB_SPIN(xb_ld(&bar[XB_XGEN(b.x)]) == gen, bar);
            __builtin_amdgcn_fence(__ATOMIC_ACQUIRE, "agent");
            asm volatile("s_waitcnt vmcnt(0)" ::: "memory");
        }
    }
    __syncthreads();
#ifdef XB_STRONG
    __builtin_amdgcn_fence(__ATOMIC_SEQ_CST, ""); asm volatile("s_waitcnt vmcnt(0)" ::: "memory"); __syncthreads();
#endif
}

__device__ __forceinline__ void cu_l1_invalidate() {
    asm volatile("s_waitcnt vmcnt(0)" ::: "memory"); __syncthreads();
    if (threadIdx.x == 0) { __builtin_amdgcn_fence(__ATOMIC_ACQUIRE, "agent"); asm volatile("s_waitcnt vmcnt(0)" ::: "memory"); }
    __syncthreads();
}
namespace pg8 {
constexpr int BM = 256, BK = 64, HALF = 128, HTB = HALF * BK * 2, STAGE_BYTES = 8 * HTB, NXCD = 8, WGM = 8;
__host__ __device__ __forceinline__ int lds_byte(int r, int c) { const int st = (r >> 4) * 2 + (c >> 5), rr = r & 15, cc = c & 31, ob = rr * 64 + cc * 2; return st * 1024 + (ob ^ (((ob >> 9) & 1) << 5)); }
__host__ __device__ __forceinline__ void stage_rc(int b, int& R, int& C) { const int st = b / 1024, sb = b % 1024, swz = sb ^ (((sb >> 9) & 1) << 5); R = (st >> 1) * 16 + swz / 64; C = (st & 1) * 32 + (swz % 64) / 2; }
__host__ __device__ __forceinline__ int perm32(int rho) { const int n = rho >> 4, i = rho & 15; return 8 * (i >> 2) + 4 * n + (i & 3); }
struct Unit { int pm, pn; };
struct Gemm { const bf16_t* A; const bf16_t* Bt; int M, N, K, lda; };
struct StaticOrder {
    int nM, nN, nwg, G, c;
    __device__ void init(int M, int N, int G_, int c_) { nM = M / BM; nN = N / BM; nwg = nM * nN; G = G_; c = c_; }
    __device__ bool next(int i, Unit& u) const {
        const long L = (long)i * G + c; if (L >= nwg) return false;
        int wgid = (int)L; { const int q = nwg / NXCD, r = nwg % NXCD, xcd = wgid % NXCD, off = wgid / NXCD; wgid = (xcd < r ? xcd * (q + 1) : r * (q + 1) + (xcd - r) * q) + off; }
        const int nig = WGM * nN, gid = wgid / nig, fm = gid * WGM, gsz = (nM - fm) < WGM ? (nM - fm) : WGM;
        u.pm = fm + ((wgid % nig) % gsz); u.pn = (wgid % nig) / gsz; return true;
    }
};
struct MoeOrder {
    int nunits, G, c; const int* blk_e;
    __device__ bool next(int i, Unit& u) const {
        if ((G & 7) == 0) { const int xcd = c & 7, s = i * (G >> 3) + (c >> 3), rb = (s >> 2) * 8 + xcd; if (rb >= (nunits >> 2)) return false; u.pm = rb; u.pn = blk_e[rb] * 4 + (s & 3); return true; }
        const int L = i * G + c; if (L >= nunits) return false; const int rb = L >> 2; u.pm = rb; u.pn = blk_e[rb] * 4 + (L & 3); return true; }
};

template <class Epi, class Sched>
__device__ __forceinline__ void gemm_phase(LAS unsigned char* lds, const Gemm g, const Sched& S, const Epi& E) {
    const int tid = opaque_tid(), wid = __builtin_amdgcn_readfirstlane(tid >> 6), lane = tid & 63, wr = wid >> 2, wc = wid & 3, fr = lane & 15, fq = lane >> 4;
    const int K = g.K, nt = K / BK, lda = g.lda;
    unsigned voffA[2], voffB[2];
#pragma unroll
    for (int i = 0; i < 2; ++i) { int R, C; stage_rc(tid * 16 + i * 8192, R, C); const int Rb = Epi::PERM ? ((R & ~31) + perm32(R & 31)) : R;
        voffA[i] = (unsigned)(R * lda + C) * 2u; voffB[i] = (unsigned)(Rb * K + C) * 2u; }
    const size_t kstep = (size_t)(BK * 2);
    const size_t hstepA = (size_t)HALF * lda * 2, hstepB = (size_t)HALF * K * 2;
    const size_t tstepA = 2 * hstepA, tstepB = 2 * hstepB;
    const unsigned ldsw = (unsigned)wid * 1024u;
    const int aoff = lds_byte(wr * 64 + fr, fq * 8), boff = lds_byte(wc * 32 + fr, fq * 8);
#define PG8_SA(b, h) (((b) * 2 + (h)) * HTB)
#define PG8_SB(b, h) ((4 + (b) * 2 + (h)) * HTB)
#define PG8_STAGE(bufoff, gbase, voff) do { _Pragma("unroll") for (int _i = 0; _i < 2; ++_i) \
        __builtin_amdgcn_global_load_lds((const unsigned*)((const char*)(gbase) + (voff)[_i]), (LAS unsigned*)(lds + (bufoff) + ldsw + _i * 8192), 16, 0, 0); } while (0)
#define PG8_LDA(dst, b, h) do { _Pragma("unroll") for (int m = 0; m < 4; ++m) _Pragma("unroll") for (int k = 0; k < 2; ++k) dst[m][k] = *(const LAS bf16x8*)(lds + PG8_SA(b, h) + aoff + m * 2048 + k * 1024); } while (0)
#define PG8_LDB(dst, b, h) do { _Pragma("unroll") for (int n = 0; n < 2; ++n) _Pragma("unroll") for (int k = 0; k < 2; ++k) dst[n][k] = *(const LAS bf16x8*)(lds + PG8_SB(b, h) + boff + n * 2048 + k * 1024); } while (0)
#define PG8_MMA(ai, bj, At, Bt) do { __builtin_amdgcn_s_setprio(1); _Pragma("unroll") for (int m = 0; m < 4; ++m) _Pragma("unroll") for (int n = 0; n < 2; ++n) _Pragma("unroll") for (int k = 0; k < 2; ++k) \
        acc[ai][bj][m][n] = __builtin_amdgcn_mfma_f32_16x16x32_bf16(Bt[n][k], At[m][k], acc[ai][bj][m][n], 0, 0, 0); __builtin_amdgcn_s_setprio(0); } while (0)
#define PG8_WAIT_V(n) asm volatile("s_waitcnt vmcnt(" #n ")" ::: "memory")
#define PG8_WAIT_L(n) asm volatile("s_waitcnt lgkmcnt(" #n ")" ::: "memory")
#define PG8_BAR __builtin_amdgcn_s_barrier()
#define PG8_SCHED __builtin_amdgcn_sched_barrier(0)
    Unit cur, nxt; int ui = 0;
    if (!S.next(0, cur)) return;
    f32x4 acc[2][2][4][2];
#pragma unroll
    for (int a = 0; a < 2; ++a)
#pragma unroll
        for (int b = 0; b < 2; ++b)
#pragma unroll
            for (int m = 0; m < 4; ++m)
#pragma unroll
                for (int n = 0; n < 2; ++n) acc[a][b][m][n] = (f32x4){0.f, 0.f, 0.f, 0.f};
    bf16x8 At[4][2], B0[2][2], B1[2][2];
    const char* cA = (const char*)g.A + (size_t)cur.pm * tstepA; const char* cB = (const char*)g.Bt + (size_t)cur.pn * tstepB;
    PG8_STAGE(PG8_SB(0, 0), cB, voffB); PG8_STAGE(PG8_SA(0, 0), cA, voffA); PG8_STAGE(PG8_SB(0, 1), cB + hstepB, voffB); PG8_STAGE(PG8_SA(0, 1), cA + hstepA, voffA);
    if (wr == 1) PG8_BAR;
    PG8_WAIT_V(4); PG8_BAR;
    PG8_STAGE(PG8_SB(1, 0), cB + kstep, voffB); PG8_STAGE(PG8_SA(1, 0), cA + kstep, voffA); PG8_STAGE(PG8_SB(1, 1), cB + hstepB + kstep, voffB);
    PG8_WAIT_V(6); PG8_BAR;
    for (;;) {
        const bool has_next = S.next(ui + 1, nxt);
        const char* nA = has_next ? (const char*)g.A + (size_t)nxt.pm * tstepA : cA; const char* nB = has_next ? (const char*)g.Bt + (size_t)nxt.pn * tstepB : cB;
        for (int t = 0; t < nt; t += 2) {
            const bool last = (t == nt - 2);
            const char* a1 = cA + (size_t)(t + 1) * kstep;
            const char* a2 = last ? nA : cA + (size_t)(t + 2) * kstep; const char* b2 = last ? nB : cB + (size_t)(t + 2) * kstep;
            const char* a3 = a2 + kstep; const char* b3 = b2 + kstep;
            PG8_LDB(B0, 0, 0); PG8_SCHED; PG8_LDA(At, 0, 0); PG8_STAGE(PG8_SA(1, 1), a1 + hstepA, voffA);
            PG8_WAIT_L(8); PG8_BAR; PG8_WAIT_L(0); PG8_MMA(0, 0, At, B0); PG8_BAR; PG8_SCHED;
            PG8_LDB(B1, 0, 1); PG8_STAGE(PG8_SB(0, 0), b2, voffB);
            PG8_BAR; PG8_WAIT_L(0); PG8_MMA(0, 1, At, B1); PG8_BAR;
            PG8_LDA(At, 0, 1); PG8_STAGE(PG8_SA(0, 0), a2, voffA);
            PG8_BAR; PG8_WAIT_L(0); PG8_MMA(1, 0, At, B0); PG8_BAR; PG8_SCHED;
            PG8_STAGE(PG8_SB(0, 1), b2 + hstepB, voffB);
            PG8_WAIT_V(6); PG8_BAR; PG8_MMA(1, 1, At, B1); PG8_BAR;
            PG8_LDB(B0, 1, 0); PG8_SCHED; PG8_LDA(At, 1, 0); PG8_STAGE(PG8_SA(0, 1), a2 + hstepA, voffA);
            PG8_WAIT_L(8); PG8_BAR; PG8_WAIT_L(0); PG8_MMA(0, 0, At, B0); PG8_BAR; PG8_SCHED;
            PG8_LDB(B1, 1, 1); PG8_STAGE(PG8_SB(1, 0), b3, voffB);
            PG8_BAR; PG8_WAIT_L(0); PG8_MMA(0, 1, At, B1); PG8_BAR;
            PG8_LDA(At, 1, 1); PG8_STAGE(PG8_SA(1, 0), a3, voffA);
            PG8_BAR; PG8_WAIT_L(0); PG8_MMA(1, 0, At, B0); PG8_BAR; PG8_SCHED;
            PG8_STAGE(PG8_SB(1, 1), b3 + hstepB, voffB);
            PG8_WAIT_V(6); PG8_BAR; PG8_MMA(1, 1, At, B1); PG8_BAR;
        }
        { int fr2 = fr, fq2 = fq; asm volatile("" : "+v"(fr2), "+v"(fq2)); E(acc, cur, wr, wc, fr2, fq2); }
        if (!has_next) break;
#pragma unroll
        for (int a = 0; a < 2; ++a)
#pragma unroll
            for (int b = 0; b < 2; ++b)
#pragma unroll
                for (int m = 0; m < 4; ++m)
#pragma unroll
                    for (int n = 0; n < 2; ++n) acc[a][b][m][n] = (f32x4){0.f, 0.f, 0.f, 0.f};
        cur = nxt; cA = nA; cB = nB; ++ui;
    }
    PG8_WAIT_V(0);
    if (wr == 0) PG8_BAR;
    PG8_BAR;
#undef PG8_SA
#undef PG8_SB
#undef PG8_STAGE
#undef PG8_LDA
#undef PG8_LDB
#undef PG8_MMA
#undef PG8_WAIT_V
#undef PG8_WAIT_L
#undef PG8_BAR
#undef PG8_SCHED
}

template <class Epi, class Sched>
__device__ __forceinline__ void gemm_phase_gather(LAS unsigned char* lds, const Gemm g, const int* stok, const Sched& S, const Epi& E) {
    const int tid = opaque_tid(), wid = __builtin_amdgcn_readfirstlane(tid >> 6), lane = tid & 63, wr = wid >> 2, wc = wid & 3, fr = lane & 15, fq = lane >> 4;
    const int K = g.K, nt = K / BK, lda = g.lda;
    unsigned voffA[2], voffB[2]; int rowA[2];
#pragma unroll
    for (int i = 0; i < 2; ++i) { int R, C; stage_rc(tid * 16 + i * 8192, R, C); const int Rb = Epi::PERM ? ((R & ~31) + perm32(R & 31)) : R;
        voffA[i] = (unsigned)C * 2u; rowA[i] = R; voffB[i] = (unsigned)(Rb * K + C) * 2u; }
    const size_t kstep = (size_t)(BK * 2);
    const size_t hstepA = (size_t)HALF * lda * 2, hstepB = (size_t)HALF * K * 2;
    const size_t tstepA = 2 * hstepA, tstepB = 2 * hstepB;
    const unsigned ldsw = (unsigned)wid * 1024u;
    const int aoff = lds_byte(wr * 64 + fr, fq * 8), boff = lds_byte(wc * 32 + fr, fq * 8);
#define PG8_SA(b, h) (((b) * 2 + (h)) * HTB)
#define PG8_SB(b, h) ((4 + (b) * 2 + (h)) * HTB)
#define PG8_STAGE(bufoff, gbase, voff) do { _Pragma("unroll") for (int _i = 0; _i < 2; ++_i) \
        __builtin_amdgcn_global_load_lds((const unsigned*)((const char*)(gbase) + (voff)[_i]), (LAS unsigned*)(lds + (bufoff) + ldsw + _i * 8192), 16, 0, 0); } while (0)
#define PG8_LDA(dst, b, h) do { _Pragma("unroll") for (int m = 0; m < 4; ++m) _Pragma("unroll") for (int k = 0; k < 2; ++k) dst[m][k] = *(const LAS bf16x8*)(lds + PG8_SA(b, h) + aoff + m * 2048 + k * 1024); } while (0)
#define PG8_LDB(dst, b, h) do { _Pragma("unroll") for (int n = 0; n < 2; ++n) _Pragma("unroll") for (int k = 0; k < 2; ++k) dst[n][k] = *(const LAS bf16x8*)(lds + PG8_SB(b, h) + boff + n * 2048 + k * 1024); } while (0)
#define PG8_MMA(ai, bj, At, Bt) do { __builtin_amdgcn_s_setprio(1); _Pragma("unroll") for (int m = 0; m < 4; ++m) _Pragma("unroll") for (int n = 0; n < 2; ++n) _Pragma("unroll") for (int k = 0; k < 2; ++k) \
        acc[ai][bj][m][n] = __builtin_amdgcn_mfma_f32_16x16x32_bf16(Bt[n][k], At[m][k], acc[ai][bj][m][n], 0, 0, 0); __builtin_amdgcn_s_setprio(0); } while (0)
#define PG8_WAIT_V(n) asm volatile("s_waitcnt vmcnt(" #n ")" ::: "memory")
#define PG8_WAIT_L(n) asm volatile("s_waitcnt lgkmcnt(" #n ")" ::: "memory")
#define PG8_BAR __builtin_amdgcn_s_barrier()
#define PG8_SCHED __builtin_amdgcn_sched_barrier(0)
    Unit cur, nxt; int ui = 0;
    if (!S.next(0, cur)) return;
    f32x4 acc[2][2][4][2];
#pragma unroll
    for (int a = 0; a < 2; ++a)
#pragma unroll
        for (int b = 0; b < 2; ++b)
#pragma unroll
            for (int m = 0; m < 4; ++m)
#pragma unroll
                for (int n = 0; n < 2; ++n) acc[a][b][m][n] = (f32x4){0.f, 0.f, 0.f, 0.f};
    bf16x8 At[4][2], B0[2][2], B1[2][2];
    const char* cA = (const char*)g.A; const char* cB = (const char*)g.Bt + (size_t)cur.pn * tstepB;
    unsigned ro[2][2], rn[2][2];
#define PGG_ROWS(dst, pm_) do { _Pragma("unroll") for (int hh = 0; hh < 2; ++hh) _Pragma("unroll") for (int ii = 0; ii < 2; ++ii) dst[hh][ii] = (unsigned)stok[(pm_) * 256 + hh * 128 + rowA[ii]] * (unsigned)(lda * 2) + voffA[ii]; } while (0)
    PGG_ROWS(ro, cur.pm);
    PG8_STAGE(PG8_SB(0, 0), cB, voffB); PG8_STAGE(PG8_SA(0, 0), cA, ro[0]); PG8_STAGE(PG8_SB(0, 1), cB + hstepB, voffB); PG8_STAGE(PG8_SA(0, 1), cA, ro[1]);
    if (wr == 1) PG8_BAR;
    PG8_WAIT_V(4); PG8_BAR;
    PG8_STAGE(PG8_SB(1, 0), cB + kstep, voffB); PG8_STAGE(PG8_SA(1, 0), cA + kstep, ro[0]); PG8_STAGE(PG8_SB(1, 1), cB + hstepB + kstep, voffB);
    PG8_WAIT_V(6); PG8_BAR;
    for (;;) {
        const bool has_next = S.next(ui + 1, nxt);
        const char* nB = has_next ? (const char*)g.Bt + (size_t)nxt.pn * tstepB : cB;
        if (has_next) PGG_ROWS(rn, nxt.pm); else { _Pragma("unroll") for (int hh = 0; hh < 2; ++hh) _Pragma("unroll") for (int ii = 0; ii < 2; ++ii) rn[hh][ii] = ro[hh][ii]; }
        for (int t = 0; t < nt; t += 2) {
            const bool last = (t == nt - 2);
            const char* a1 = cA + (size_t)(t + 1) * kstep;
            const char* a2 = last ? cA : cA + (size_t)(t + 2) * kstep; const char* b2 = last ? nB : cB + (size_t)(t + 2) * kstep;
            const char* a3 = a2 + kstep; const char* b3 = b2 + kstep;
            PG8_LDB(B0, 0, 0); PG8_SCHED; PG8_LDA(At, 0, 0); PG8_STAGE(PG8_SA(1, 1), a1, ro[1]);
            PG8_WAIT_L(8); PG8_BAR; PG8_WAIT_L(0); PG8_MMA(0, 0, At, B0); PG8_BAR; PG8_SCHED;
            PG8_LDB(B1, 0, 1); PG8_STAGE(PG8_SB(0, 0), b2, voffB);
            PG8_BAR; PG8_WAIT_L(0); PG8_MMA(0, 1, At, B1); PG8_BAR;
            PG8_LDA(At, 0, 1); if (last) PG8_STAGE(PG8_SA(0, 0), a2, rn[0]); else PG8_STAGE(PG8_SA(0, 0), a2, ro[0]);
            PG8_BAR; PG8_WAIT_L(0); PG8_MMA(1, 0, At, B0); PG8_BAR; PG8_SCHED;
            PG8_STAGE(PG8_SB(0, 1), b2 + hstepB, voffB);
            PG8_WAIT_V(6); PG8_BAR; PG8_MMA(1, 1, At, B1); PG8_BAR;
            PG8_LDB(B0, 1, 0); PG8_SCHED; PG8_LDA(At, 1, 0); if (last) PG8_STAGE(PG8_SA(0, 1), a2, rn[1]); else PG8_STAGE(PG8_SA(0, 1), a2, ro[1]);
            PG8_WAIT_L(8); PG8_BAR; PG8_WAIT_L(0); PG8_MMA(0, 0, At, B0); PG8_BAR; PG8_SCHED;
            PG8_LDB(B1, 1, 1); PG8_STAGE(PG8_SB(1, 0), b3, voffB);
            PG8_BAR; PG8_WAIT_L(0); PG8_MMA(0, 1, At, B1); PG8_BAR;
            PG8_LDA(At, 1, 1); if (last) PG8_STAGE(PG8_SA(1, 0), a3, rn[0]); else PG8_STAGE(PG8_SA(1, 0), a3, ro[0]);
            PG8_BAR; PG8_WAIT_L(0); PG8_MMA(1, 0, At, B0); PG8_BAR; PG8_SCHED;
            PG8_STAGE(PG8_SB(1, 1), b3 + hstepB, voffB);
            PG8_WAIT_V(6); PG8_BAR; PG8_MMA(1, 1, At, B1); PG8_BAR;
        }
        { int fr2 = fr, fq2 = fq; asm volatile("" : "+v"(fr2), "+v"(fq2)); E(acc, cur, wr, wc, fr2, fq2); }
        if (!has_next) break;
#pragma unroll
        for (int a = 0; a < 2; ++a)
#pragma unroll
            for (int b = 0; b < 2; ++b)
#pragma unroll
                for (int m = 0; m < 4; ++m)
#pragma unroll
                    for (int n = 0; n < 2; ++n) acc[a][b][m][n] = (f32x4){0.f, 0.f, 0.f, 0.f};
        cur = nxt; cB = nB; ++ui;
#pragma unroll
        for (int hh = 0; hh < 2; ++hh)
#pragma unroll
            for (int ii = 0; ii < 2; ++ii) ro[hh][ii] = rn[hh][ii];
    }
    PG8_WAIT_V(0);
    if (wr == 0) PG8_BAR;
    PG8_BAR;
#undef PGG_ROWS
#undef PG8_SA
#undef PG8_SB
#undef PG8_STAGE
#undef PG8_LDA
#undef PG8_LDB
#undef PG8_MMA
#undef PG8_WAIT_V
#undef PG8_WAIT_L
#undef PG8_BAR
#undef PG8_SCHED
}

typedef f32x4 AccT[2][2][4][2];
__device__ __forceinline__ u32x4 pack8(f32x4 v0, f32x4 v1) { return (u32x4){cvt_pk_bf16(v0[0], v0[1]), cvt_pk_bf16(v0[2], v0[3]), cvt_pk_bf16(v1[0], v1[1]), cvt_pk_bf16(v1[2], v1[3])}; }
struct MergeArgs { const bf16_t* A; const bf16_t* Bt; const bf16_t* gates; bf16_t* merged; int M; };
__device__ __forceinline__ void gemm_phase_merge(LAS unsigned char* lds, const MergeArgs g, const StaticOrder& S) {
    const int tid = opaque_tid(), wid = __builtin_amdgcn_readfirstlane(tid >> 6), lane = tid & 63, wr = wid >> 2, wc = wid & 3, fr = lane & 15, fq = lane >> 4;
    constexpr int K = 1024, nt = 16;
    unsigned voffA[2], voffB[2];
#pragma unroll
    for (int i = 0; i < 2; ++i) { int R, C; stage_rc(tid * 16 + i * 8192, R, C); const int Rb = (R & ~31) + perm32(R & 31);
        voffA[i] = (unsigned)(R * K + C) * 2u; voffB[i] = (unsigned)(Rb * K + C) * 2u; }
    const size_t kstep = (size_t)(BK * 2), hstep = (size_t)HALF * K * 2, tstep = 2 * hstep;
    const unsigned ldsw = (unsigned)wid * 1024u;
    const int aoff = lds_byte(wr * 64 + fr, fq * 8), boff = lds_byte(wc * 32 + fr, fq * 8);
#define PG8_SA(b, h) (((b) * 2 + (h)) * HTB)
#define PG8_SB(b, h) ((4 + (b) * 2 + (h)) * HTB)
#define PG8_STAGE(bufoff, gbase, voff) do { _Pragma("unroll") for (int _i = 0; _i < 2; ++_i) \
        __builtin_amdgcn_global_load_lds((const unsigned*)((const char*)(gbase) + (voff)[_i]), (LAS unsigned*)(lds + (bufoff) + ldsw + _i * 8192), 16, 0, 0); } while (0)
#define PG8_LDA(dst, b, h) do { _Pragma("unroll") for (int m = 0; m < 4; ++m) _Pragma("unroll") for (int k = 0; k < 2; ++k) dst[m][k] = *(const LAS bf16x8*)(lds + PG8_SA(b, h) + aoff + m * 2048 + k * 1024); } while (0)
#define PG8_LDB(dst, b, h) do { _Pragma("unroll") for (int n = 0; n < 2; ++n) _Pragma("unroll") for (int k = 0; k < 2; ++k) dst[n][k] = *(const LAS bf16x8*)(lds + PG8_SB(b, h) + boff + n * 2048 + k * 1024); } while (0)
#define PG8_MMA(ai, bj, At, Bt) do { __builtin_amdgcn_s_setprio(1); _Pragma("unroll") for (int m = 0; m < 4; ++m) _Pragma("unroll") for (int n = 0; n < 2; ++n) _Pragma("unroll") for (int k = 0; k < 2; ++k) \
        acc[ai][bj][m][n] = __builtin_amdgcn_mfma_f32_16x16x32_bf16(Bt[n][k], At[m][k], acc[ai][bj][m][n], 0, 0, 0); __builtin_amdgcn_s_setprio(0); } while (0)
#define PG8_WAIT_V(n) asm volatile("s_waitcnt vmcnt(" #n ")" ::: "memory")
#define PG8_WAIT_L(n) asm volatile("s_waitcnt lgkmcnt(" #n ")" ::: "memory")
#define PG8_BAR __builtin_amdgcn_s_barrier()
#define PG8_SCHED __builtin_amdgcn_sched_barrier(0)
#define PGM_RESCALE(gx, gy) do { int fr2 = fr, fq2 = fq; asm volatile("" : "+v"(fr2), "+v"(fq2)); \
        const bf16_t* gp0_ = g.gates + ((size_t)cur.pm * BM + wr * 64 + fr2) * 3072 + cur.pn * 256 + wc * 32 + 8 * fq2; \
        _Pragma("unroll") for (int ai = 0; ai < 2; ++ai) { u32x4 xw[4][2], yw[4][2]; \
            _Pragma("unroll") for (int m = 0; m < 4; ++m) _Pragma("unroll") for (int bj = 0; bj < 2; ++bj) { const bf16_t* gp = gp0_ + (size_t)(ai * HALF + m * 16) * 3072 + bj * HALF; \
                xw[m][bj] = *(const u32x4*)(gp + (gx) * 1024); yw[m][bj] = *(const u32x4*)(gp + (gy) * 1024); } \
            _Pragma("unroll") for (int m = 0; m < 4; ++m) _Pragma("unroll") for (int bj = 0; bj < 2; ++bj) { float nx[8], ny[8]; unpack8(xw[m][bj], nx); unpack8(yw[m][bj], ny); \
                _Pragma("unroll") for (int e = 0; e < 8; ++e) acc[ai][bj][m][e >> 2][e & 3] *= ny[e] * __builtin_amdgcn_rcpf(nx[e]); } \
            __builtin_amdgcn_sched_barrier(0); } } while (0)
    Unit cur, nxt; int ui = 0;
    if (!S.next(0, cur)) return;
    f32x4 acc[2][2][4][2];
#pragma unroll
    for (int a = 0; a < 2; ++a)
#pragma unroll
        for (int b = 0; b < 2; ++b)
#pragma unroll
            for (int m = 0; m < 4; ++m)
#pragma unroll
                for (int n = 0; n < 2; ++n) acc[a][b][m][n] = (f32x4){0.f, 0.f, 0.f, 0.f};
    bf16x8 At[4][2], B0[2][2], B1[2][2];
    const char* cA = (const char*)g.A + (size_t)cur.pm * tstep; const char* cB = (const char*)g.Bt + (size_t)cur.pn * tstep;
    PG8_STAGE(PG8_SB(0, 0), cB, voffB); PG8_STAGE(PG8_SA(0, 0), cA, voffA); PG8_STAGE(PG8_SB(0, 1), cB + hstep, voffB); PG8_STAGE(PG8_SA(0, 1), cA + hstep, voffA);
    if (wr == 1) PG8_BAR;
    PG8_WAIT_V(4); PG8_BAR;
    PG8_STAGE(PG8_SB(1, 0), cB + kstep, voffB); PG8_STAGE(PG8_SA(1, 0), cA + kstep, voffA); PG8_STAGE(PG8_SB(1, 1), cB + hstep + kstep, voffB);
    PG8_WAIT_V(6); PG8_BAR;
    for (;;) {
        const bool has_next = S.next(ui + 1, nxt);
        const char* nA = has_next ? (const char*)g.A + (size_t)nxt.pm * tstep : cA; const char* nB = has_next ? (const char*)g.Bt + (size_t)nxt.pn * tstep : cB;
#define PGM_ITER(t) do { \
            const bool last = ((t) == nt - 2); \
            const char* a1 = cA + (size_t)((t) + 1) * kstep; \
            const char* a2 = last ? nA : cA + (size_t)((t) + 2) * kstep; const char* b2 = last ? nB : cB + (size_t)((t) + 2) * kstep; \
            const char* a3 = a2 + kstep; const char* b3 = b2 + kstep; \
            PG8_LDB(B0, 0, 0); PG8_SCHED; PG8_LDA(At, 0, 0); PG8_STAGE(PG8_SA(1, 1), a1 + hstep, voffA); \
            PG8_WAIT_L(8); PG8_BAR; PG8_WAIT_L(0); PG8_MMA(0, 0, At, B0); PG8_BAR; PG8_SCHED; \
            PG8_LDB(B1, 0, 1); PG8_STAGE(PG8_SB(0, 0), b2, voffB); \
            PG8_BAR; PG8_WAIT_L(0); PG8_MMA(0, 1, At, B1); PG8_BAR; \
            PG8_LDA(At, 0, 1); PG8_STAGE(PG8_SA(0, 0), a2, voffA); \
            PG8_BAR; PG8_WAIT_L(0); PG8_MMA(1, 0, At, B0); PG8_BAR; PG8_SCHED; \
            PG8_STAGE(PG8_SB(0, 1), b2 + hstep, voffB); \
            PG8_WAIT_V(6); PG8_BAR; PG8_MMA(1, 1, At, B1); PG8_BAR; \
            PG8_LDB(B0, 1, 0); PG8_SCHED; PG8_LDA(At, 1, 0); PG8_STAGE(PG8_SA(0, 1), a2 + hstep, voffA); \
            PG8_WAIT_L(8); PG8_BAR; PG8_WAIT_L(0); PG8_MMA(0, 0, At, B0); PG8_BAR; PG8_SCHED; \
            PG8_LDB(B1, 1, 1); PG8_STAGE(PG8_SB(1, 0), b3, voffB); \
            PG8_BAR; PG8_WAIT_L(0); PG8_MMA(0, 1, At, B1); PG8_BAR; \
            PG8_LDA(At, 1, 1); PG8_STAGE(PG8_SA(1, 0), a3, voffA); \
            PG8_BAR; PG8_WAIT_L(0); PG8_MMA(1, 0, At, B0); PG8_BAR; PG8_SCHED; \
            PG8_STAGE(PG8_SB(1, 1), b3 + hstep, voffB); \
            PG8_WAIT_V(6); PG8_BAR; PG8_MMA(1, 1, At, B1); PG8_BAR; } while (0)
#pragma unroll 1
        for (int t = 0; t < 8; t += 2) PGM_ITER(t);
        PGM_RESCALE(0, 1);
#pragma unroll 1
        for (int t = 8; t < 12; t += 2) PGM_ITER(t);
        PGM_RESCALE(1, 2);
#pragma unroll 1
        for (int t = 12; t < 16; t += 2) PGM_ITER(t);
#undef PGM_ITER
        {
            int fr2 = fr, fq2 = fq; asm volatile("" : "+v"(fr2), "+v"(fq2));
            const size_t row0 = (size_t)cur.pm * BM + wr * 64 + fr2; const int col0 = cur.pn * 256 + wc * 32 + 8 * fq2;
#pragma unroll
            for (int ai = 0; ai < 2; ++ai)
#pragma unroll
                for (int mp = 0; mp < 2; ++mp) { u32x4 gw[2][2];
#pragma unroll
                    for (int mm = 0; mm < 2; ++mm)
#pragma unroll
                        for (int bj = 0; bj < 2; ++bj) gw[mm][bj] = *(const u32x4*)(g.gates + (row0 + ai * HALF + (2 * mp + mm) * 16) * 3072 + 2048 + col0 + bj * HALF);
#pragma unroll
                    for (int mm = 0; mm < 2; ++mm)
#pragma unroll
                        for (int bj = 0; bj < 2; ++bj) { const int m = 2 * mp + mm; float gg[8]; unpack8(gw[mm][bj], gg); f32x4 v0 = acc[ai][bj][m][0], v1 = acc[ai][bj][m][1];
#pragma unroll
                            for (int e = 0; e < 4; ++e) { v0[e] *= __builtin_amdgcn_rcpf(gg[e]); v1[e] *= __builtin_amdgcn_rcpf(gg[4 + e]); }
                            *(u32x4*)(g.merged + (row0 + ai * HALF + m * 16) * 1024 + col0 + bj * HALF) = pack8(v0, v1); }
                    __builtin_amdgcn_sched_barrier(0); }
        }
        if (!has_next) break;
#pragma unroll
        for (int a = 0; a < 2; ++a)
#pragma unroll
            for (int b = 0; b < 2; ++b)
#pragma unroll
                for (int m = 0; m < 4; ++m)
#pragma unroll
                    for (int n = 0; n < 2; ++n) acc[a][b][m][n] = (f32x4){0.f, 0.f, 0.f, 0.f};
        cur = nxt; cA = nA; cB = nB; ++ui;
    }
    PG8_WAIT_V(0);
    if (wr == 0) PG8_BAR;
    PG8_BAR;
#undef PG8_SA
#undef PG8_SB
#undef PG8_STAGE
#undef PGM_RESCALE
#undef PG8_LDA
#undef PG8_LDB
#undef PG8_MMA
#undef PG8_WAIT_V
#undef PG8_WAIT_L
#undef PG8_BAR
#undef PG8_SCHED
}


struct EpiInproj {
    static constexpr bool PERM = true;
    bf16_t* u_att; bf16_t* u_s5; bf16_t* u_rw; int pm_off = 0, pn_off = 0;
    __device__ __forceinline__ void operator()(const AccT& acc, const Unit& u, int wr, int wc, int fr, int fq) const {
        const int pn = u.pn + pn_off;
        const int row0 = (u.pm + pm_off) * BM + wr * 64 + fr; bf16_t* base; int ld, colt;
        if (pn < 4) { base = u_att; ld = 1024; colt = pn * 256; } else if (pn == 4) { base = u_s5; ld = 256; colt = 0; } else { base = u_rw; ld = 1024; colt = (pn - 5) * 256; }
        const int col0 = colt + wc * 32 + 8 * fq;
#pragma unroll
        for (int ai = 0; ai < 2; ++ai)
#pragma unroll
            for (int m = 0; m < 4; ++m) { bf16_t* rowp = base + (size_t)(row0 + ai * HALF + m * 16) * ld + col0;
#pragma unroll
                for (int bj = 0; bj < 2; ++bj) *(u32x4*)(rowp + bj * HALF) = pack8(acc[ai][bj][m][0], acc[ai][bj][m][1]); }
    }
};
struct EpiLora {
    static constexpr bool PERM = true;
    bf16_t* out; const float* w0; const float* a0;
    __device__ __forceinline__ void operator()(const AccT& acc, const Unit& u, int wr, int wc, int fr, int fq) const {
        const int row0 = u.pm * BM + wr * 64 + fr, kind = u.pn; bf16_t* base = out + (size_t)kind * NTOK * 256;
        const int col0 = wc * 32 + 8 * fq;
        const float* bp = kind < 2 ? w0 + kind * 256 : a0 + (kind & 1) * 256;
        const float sc = kind < 2 ? 0.6065306597126334f : 1.0f;
#pragma unroll
        for (int bj = 0; bj < 2; ++bj) {
            f32x4 b0 = (f32x4){0.f, 0.f, 0.f, 0.f}, b1 = b0;
            if (kind < 4) { b0 = *(const f32x4*)(bp + col0 + bj * HALF); b1 = *(const f32x4*)(bp + col0 + bj * HALF + 4); }
#pragma unroll
            for (int ai = 0; ai < 2; ++ai)
#pragma unroll
                for (int m = 0; m < 4; ++m) { bf16_t* rowp = base + (size_t)(row0 + ai * HALF + m * 16) * 256 + col0;
                    f32x4 v0 = acc[ai][bj][m][0] + b0, v1 = acc[ai][bj][m][1] + b1;
                    if (kind < 4) {
#pragma unroll
                        for (int e = 0; e < 4; ++e) { v0[e] = sc * sigmoidf_(v0[e]); v1[e] = sc * sigmoidf_(v1[e]); } }
                    *(u32x4*)(rowp + bj * HALF) = pack8(v0, v1); __builtin_amdgcn_sched_barrier(0); }
        }
    }
};
struct EpiGlu {
    static constexpr bool PERM = true;
    bf16_t* o;
    __device__ __forceinline__ void operator()(const AccT& acc, const Unit& u, int wr, int wc, int fr, int fq) const {
        const int row0 = u.pm * BM + wr * 64 + fr; const int col0 = u.pn * 256 + wc * 32 + 8 * fq;
#pragma unroll
        for (int ai = 0; ai < 2; ++ai)
#pragma unroll
            for (int m = 0; m < 4; ++m) { bf16_t* rowp = o + (size_t)(row0 + ai * HALF + m * 16) * 1024;
#pragma unroll
                for (int bj = 0; bj < 2; ++bj) { const f32x4 v = acc[ai][bj][m][0], gt = acc[ai][bj][m][1]; const int j0 = (col0 + bj * HALF) >> 1;
                    *(u32x2*)(rowp + j0) = (u32x2){cvt_pk_bf16(v[0] * sigmoidf_(gt[0]), v[1] * sigmoidf_(gt[1])), cvt_pk_bf16(v[2] * sigmoidf_(gt[2]), v[3] * sigmoidf_(gt[3]))}; } }
    }
};
struct EpiGates {
    static constexpr bool PERM = true;
    bf16_t* o;
    __device__ __forceinline__ void operator()(const AccT& acc, const Unit& u, int wr, int wc, int fr, int fq) const {
        const int row0 = u.pm * BM + wr * 64 + fr; const int col0 = u.pn * 256 + wc * 32 + 8 * fq;
#pragma unroll
        for (int ai = 0; ai < 2; ++ai)
#pragma unroll
            for (int m = 0; m < 4; ++m) { bf16_t* rowp = o + (size_t)(row0 + ai * HALF + m * 16) * 3072 + col0;
#pragma unroll
                for (int bj = 0; bj < 2; ++bj) { f32x4 v0 = acc[ai][bj][m][0], v1 = acc[ai][bj][m][1];
#pragma unroll
                    for (int e = 0; e < 4; ++e) { v0[e] = fminf(1.0f + __builtin_amdgcn_exp2f(-1.4426950408889634f * v0[e]), 1e30f); v1[e] = fminf(1.0f + __builtin_amdgcn_exp2f(-1.4426950408889634f * v1[e]), 1e30f); }
                    *(u32x4*)(rowp + bj * HALF) = pack8(v0, v1); } }
    }
};
template <bool FIRST> struct EpiMerge {
    static constexpr bool PERM = true;
    bf16_t* merged; const bf16_t* gates; int br;
    __device__ __forceinline__ void operator()(const AccT& acc, const Unit& u, int wr, int wc, int fr, int fq) const {
        const int row0 = u.pm * BM + wr * 64 + fr; const int col0 = u.pn * 256 + wc * 32 + 8 * fq;
#pragma unroll
        for (int ai = 0; ai < 2; ++ai) {
            u32x4 gw[4][2], mw[4][2];
#pragma unroll
            for (int m = 0; m < 4; ++m)
#pragma unroll
                for (int bj = 0; bj < 2; ++bj) { const size_t row = (size_t)(row0 + ai * HALF + m * 16); const int c = col0 + bj * HALF;
                    gw[m][bj] = *(const u32x4*)(gates + row * 3072 + br * 1024 + c);
                    if (!FIRST) mw[m][bj] = *(const u32x4*)(merged + row * 1024 + c); }
#pragma unroll
            for (int m = 0; m < 4; ++m)
#pragma unroll
                for (int bj = 0; bj < 2; ++bj) { const size_t row = (size_t)(row0 + ai * HALF + m * 16); const int c = col0 + bj * HALF;
                    f32x4 v0 = acc[ai][bj][m][0], v1 = acc[ai][bj][m][1]; const u32x4 g = gw[m][bj];
                    v0[0] *= bflo(g[0]); v0[1] *= bfhi(g[0]); v0[2] *= bflo(g[1]); v0[3] *= bfhi(g[1]);
                    v1[0] *= bflo(g[2]); v1[1] *= bfhi(g[2]); v1[2] *= bflo(g[3]); v1[3] *= bfhi(g[3]);
                    if (!FIRST) { const u32x4 w = mw[m][bj];
                        v0[0] += bflo(w[0]); v0[1] += bfhi(w[0]); v0[2] += bflo(w[1]); v0[3] += bfhi(w[1]);
                        v1[0] += bflo(w[2]); v1[1] += bfhi(w[2]); v1[2] += bflo(w[3]); v1[3] += bfhi(w[3]); }
                    *(u32x4*)(merged + row * 1024 + c) = pack8(v0, v1); }
            __builtin_amdgcn_sched_barrier(0);
        }
    }
};
struct EpiResid {
    static constexpr bool PERM = false;
    const float* xin_lat; const float* xin_ctx; float* xout_lat; float* xout_ctx; const float* g1;
    __device__ __forceinline__ void operator()(const AccT& acc, const Unit& u, int wr, int wc, int fr, int fq) const {
        const int rowb = u.pm * BM; const bool lat = rowb < NLAT; const int mr = lat ? (rowb >> 11) : 32;
        const float* xin = lat ? xin_lat + (size_t)rowb * D : xin_ctx + (size_t)(rowb - NLAT) * D;
        float* xo = lat ? xout_lat + (size_t)rowb * D : xout_ctx + (size_t)(rowb - NLAT) * D;
        const int r0 = wr * 64 + fr, col0 = u.pn * BM + wc * 32 + 4 * fq;
        f32x4 gv[2][2];
#pragma unroll
        for (int bj = 0; bj < 2; ++bj)
#pragma unroll
            for (int n = 0; n < 2; ++n) gv[bj][n] = *(const f32x4*)(g1 + (size_t)mr * MODW + col0 + bj * HALF + n * 16);
#pragma unroll
        for (int ai = 0; ai < 2; ++ai) {
            f32x4 xv[4][2][2];
#pragma unroll
            for (int m = 0; m < 4; ++m)
#pragma unroll
                for (int bj = 0; bj < 2; ++bj)
#pragma unroll
                    for (int n = 0; n < 2; ++n) xv[m][bj][n] = *(const f32x4*)(xin + (size_t)(r0 + ai * HALF + m * 16) * D + col0 + bj * HALF + n * 16);
#pragma unroll
            for (int m = 0; m < 4; ++m)
#pragma unroll
                for (int bj = 0; bj < 2; ++bj)
#pragma unroll
                    for (int n = 0; n < 2; ++n) *(f32x4*)(xo + (size_t)(r0 + ai * HALF + m * 16) * D + col0 + bj * HALF + n * 16) = xv[m][bj][n] + gv[bj][n] * acc[ai][bj][m][n];
            __builtin_amdgcn_sched_barrier(0);
        }
    }
};
struct EpiLogits {
    static constexpr bool PERM = false;
    float* o;
    __device__ __forceinline__ void operator()(const AccT& acc, const Unit& u, int wr, int wc, int fr, int fq) const {
        if (wc >= 2) return;
        const int row0 = u.pm * BM + wr * 64 + fr, col0 = wc * 32 + 4 * fq;
#pragma unroll
        for (int ai = 0; ai < 2; ++ai)
#pragma unroll
            for (int m = 0; m < 4; ++m) { float* rowp = o + (size_t)(row0 + ai * HALF + m * 16) * 64 + col0;
#pragma unroll
                for (int n = 0; n < 2; ++n) *(f32x4*)(rowp + n * 16) = acc[ai][0][m][n]; }
    }
};
struct EpiGU {
    static constexpr bool PERM = true;
    bf16_t* o;
    __device__ __forceinline__ void operator()(const AccT& acc, const Unit& u, int wr, int wc, int fr, int fq) const {
        const int row0 = u.pm * BM + wr * 64 + fr; const int col0 = (u.pn & 3) * 256 + wc * 32 + 8 * fq;
#pragma unroll
        for (int ai = 0; ai < 2; ++ai)
#pragma unroll
            for (int m = 0; m < 4; ++m) { bf16_t* rowp = o + (size_t)(row0 + ai * HALF + m * 16) * 512;
#pragma unroll
                for (int bj = 0; bj < 2; ++bj) { const f32x4 gt = acc[ai][bj][m][0], up = acc[ai][bj][m][1]; const int j0 = (col0 + bj * HALF) >> 1;
                    *(u32x2*)(rowp + j0) = (u32x2){cvt_pk_bf16(gt[0] * sigmoidf_(gt[0]) * up[0], gt[1] * sigmoidf_(gt[1]) * up[1]), cvt_pk_bf16(gt[2] * sigmoidf_(gt[2]) * up[2], gt[3] * sigmoidf_(gt[3]) * up[3])}; } }
    }
};
struct EpiDown {
    static constexpr bool PERM = true;
    bf16_t* o; const float* sgate;
    __device__ __forceinline__ void operator()(const AccT& acc, const Unit& u, int wr, int wc, int fr, int fq) const {
        const int row0 = u.pm * BM + wr * 64 + fr; const int col0 = (u.pn & 3) * 256 + wc * 32 + 8 * fq;
#pragma unroll
        for (int ai = 0; ai < 2; ++ai)
#pragma unroll
            for (int m = 0; m < 4; ++m) { const int row = row0 + ai * HALF + m * 16; const float w = sgate[row]; bf16_t* rowp = o + (size_t)row * 1024 + col0;
#pragma unroll
                for (int bj = 0; bj < 2; ++bj) *(u32x4*)(rowp + bj * HALF) = pack8(acc[ai][bj][m][0] * w, acc[ai][bj][m][1] * w); }
    }
};
}

__device__ __forceinline__ void phase_mod(unsigned char* shm, const float* c, const float* c_ctx, const float* w_mod, const float* b_mod, float* mod) {
    const int tid = opaque_tid();
    float* s = (float*)shm;
    for (int idx = tid; idx < 33 * 1024; idx += 512) { const int r = idx >> 10, k = idx & 1023; const float v = (r < 32) ? c[r * 1024 + k] : c_ctx[k]; s[idx] = v / (1.0f + __expf(-v)); }
    __syncthreads();
    const int j = tid & 63, kc = tid >> 6;
    for (int u = blockIdx.x; u < 2 * 96; u += gridDim.x) {
        const int l = u / 96, col0 = (u % 96) * 64;
        float acc[33];
#pragma unroll
        for (int r = 0; r < 33; ++r) acc[r] = 0.f;
        const float* wp = w_mod + (size_t)l * D * MODW + col0 + j;
        for (int k = kc * 128; k < kc * 128 + 128; k += 4) {
            const float w0 = wp[(size_t)k * MODW], w1 = wp[(size_t)(k + 1) * MODW], w2 = wp[(size_t)(k + 2) * MODW], w3 = wp[(size_t)(k + 3) * MODW];
#pragma unroll
            for (int r = 0; r < 33; ++r) { const f32x4 sv = *(const f32x4*)(s + r * 1024 + k); acc[r] += sv[0] * w0 + sv[1] * w1 + sv[2] * w2 + sv[3] * w3; }
        }
        float* acc_s = (float*)(shm + 135168);
        for (int w = 0; w < 8; ++w) {
            if (kc == w) {
#pragma unroll
                for (int r = 0; r < 33; ++r) { if (w == 0) acc_s[r * 64 + j] = acc[r]; else acc_s[r * 64 + j] += acc[r]; }
            }
            __syncthreads();
        }
        for (int o = tid; o < 33 * 64; o += 512) { const int r = o >> 6, jj = o & 63; mod[((size_t)l * 33 + r) * MODW + col0 + jj] = acc_s[o] + b_mod[l * MODW + col0 + jj]; }
        __syncthreads();
    }
}

template <int MAP  >
__device__ __forceinline__ void cvt_tile(unsigned char* shm, const float* src, int ldS, int k0, int n0, bf16_t* dst, int ldD, int kdst0, int nrow0, int half) {
    float* tile = (float*)shm;
    const int tid = opaque_tid();
    {
        const int kk = tid >> 4, nn = (tid & 15) * 4;
#pragma unroll
        for (int p = 0; p < 2; ++p) { const int k = kk + p * 32;
            f32x4 v = (f32x4){0.f, 0.f, 0.f, 0.f}; if (src) v = *(const f32x4*)(src + (size_t)(k0 + k) * ldS + n0 + nn);
            tile[k * 65 + nn] = v[0]; tile[k * 65 + nn + 1] = v[1]; tile[k * 65 + nn + 2] = v[2]; tile[k * 65 + nn + 3] = v[3]; }
    }
    __syncthreads();
    {
        const int nn = tid >> 3, k8 = (tid & 7) * 8; int n = n0 + nn;
        if (MAP == 1) { const int hh = n >= half ? 1 : 0, jj = n - hh * half; n = 8 * (jj >> 2) + 4 * hh + (jj & 3); }
        float v[8];
#pragma unroll
        for (int i = 0; i < 8; ++i) v[i] = tile[(k8 + i) * 65 + nn];
        *(u32x4*)(dst + (size_t)(nrow0 + n) * ldD + kdst0 + k8) = (u32x4){cvt_pk_bf16(v[0], v[1]), cvt_pk_bf16(v[2], v[3]), cvt_pk_bf16(v[4], v[5]), cvt_pk_bf16(v[6], v[7])};
    }
    __syncthreads();
}
template <int MAP>
__device__ __forceinline__ void cvt_tile4(unsigned char* shm, const float* src, int ldS, int k0, int n0, bf16_t* dst, int ldD, int kdst0, int nrow0, int half) {
    float* tile = (float*)shm;
    const int tid = opaque_tid();
    {
        const int kk = tid >> 6, nn = (tid & 63) * 4;
        f32x4 v[8];
#pragma unroll
        for (int p = 0; p < 8; ++p) v[p] = *(const f32x4*)(src + (size_t)(k0 + kk + 8 * p) * ldS + n0 + nn);
#pragma unroll
        for (int p = 0; p < 8; ++p) { float* tp = tile + (kk + 8 * p) * 257 + nn; tp[0] = v[p][0]; tp[1] = v[p][1]; tp[2] = v[p][2]; tp[3] = v[p][3]; }
    }
    __syncthreads();
    {
        const int nn = tid >> 1, kh = (tid & 1) * 32; int n = n0 + nn;
        if (MAP == 1) { const int hh = n >= half ? 1 : 0, jj = n - hh * half; n = 8 * (jj >> 2) + 4 * hh + (jj & 3); }
        bf16_t* dp = dst + (size_t)(nrow0 + n) * ldD + kdst0 + kh;
#pragma unroll
        for (int q = 0; q < 4; ++q) { float v[8];
#pragma unroll
            for (int i = 0; i < 8; ++i) v[i] = tile[(kh + 8 * q + i) * 257 + nn];
            *(u32x4*)(dp + 8 * q) = (u32x4){cvt_pk_bf16(v[0], v[1]), cvt_pk_bf16(v[2], v[3]), cvt_pk_bf16(v[4], v[5]), cvt_pk_bf16(v[6], v[7])}; }
    }
    __syncthreads();
}
__device__ __forceinline__ void phase_cvt_small(unsigned char* shm, LAS unsigned char* lds, int l, bf16_t* W) {
    const float* w_in = INP(7) + (size_t)l * D * INW;
    const float* w_glu = INP(18) + (size_t)l * 256 * 512;
    const float* w2 = INP(21) + (size_t)l * 2 * 64 * 256;
    const float* a2 = INP(23) + (size_t)l * 2 * 64 * 256;
    const float* g2 = INP(24) + (size_t)l * 128 * 256;
    const float* p_att = INP(30) + (size_t)l * 512 * 1024;
    const float* p_s5 = INP(31) + (size_t)l * 256 * 1024;
    const float* p_rw = INP(32) + (size_t)l * 256 * 1024;
    const float* w_out = INP(33) + (size_t)l * 1024 * 1024;
    constexpr int T_IN = 16 * 21, T_GLU = 4 * 2, T_PA = 8 * 4, T_PS = 4 * 4, T_PR = 4 * 4, T_OUT = 16 * 4, T_LORA = 20 * 4;
    constexpr int E_IN = T_IN, E_GLU = E_IN + T_GLU, E_PA = E_GLU + T_PA, E_PS = E_PA + T_PS, E_PR = E_PS + T_PR, E_OUT = E_PR + T_OUT, E_LORA = E_OUT + T_LORA;
    for (int t = blockIdx.x; t < E_LORA; t += gridDim.x) {
        if (t < E_IN) { const int tk = t / 21, tn = t % 21; cvt_tile4<0>(shm, w_in, INW, tk * 64, tn * 256, W + SW_IN, 1024, tk * 64, 0, 0); }
        else if (t < E_GLU) { const int q = t - E_IN, tk = q / 2, tn = q % 2; cvt_tile4<1>(shm, w_glu, 512, tk * 64, tn * 256, W + SW_GLU, 256, tk * 64, 0, 256); }
        else if (t < E_PA) { const int q = t - E_GLU, tk = q / 4, tn = q % 4; cvt_tile4<0>(shm, p_att, 1024, tk * 64, tn * 256, W + SW_PA, 1024, tk * 64, 0, 0); }
        else if (t < E_PS) { const int q = t - E_PA, tk = q / 4, tn = q % 4; cvt_tile4<0>(shm, p_s5, 1024, tk * 64, tn * 256, W + SW_PA, 1024, 512 + tk * 64, 0, 0); }
        else if (t < E_PR) { const int q = t - E_PS, tk = q / 4, tn = q % 4; cvt_tile4<0>(shm, p_rw, 1024, tk * 64, tn * 256, W + SW_PA, 1024, 768 + tk * 64, 0, 0); }
        else if (t < E_OUT) { const int q = t - E_PR, tk = q / 4, tn = q % 4; cvt_tile4<0>(shm, w_out, 1024, tk * 64, tn * 256, W + SW_OUT, 1024, tk * 64, 0, 0); }
        else { const int q = t - E_OUT, tn = q / 4, tk = q % 4, seg = tn / 4, tnl = tn % 4;
            const float* src = nullptr; int k0 = 0;
            if (seg < 2) { if (tk == 0) { src = w2 + (size_t)seg * 64 * 256; k0 = 0; } }
            else if (seg < 4) { if (tk == 1) { src = a2 + (size_t)(seg - 2) * 64 * 256; k0 = 0; } }
            else { if (tk >= 2) { src = g2; k0 = (tk - 2) * 64; } }
            cvt_tile<0>(shm, src, 256, k0, tnl * 64, W + SW_LORA, 256, tk * 64, seg * 256, 0); }
    }
    const float* rg = INP(35) + (size_t)l * 1024 * 4; const float* re = INP(37) + (size_t)l * 1024 * 32;
    for (int idx = blockIdx.x * 512 + opaque_tid(); idx < 256 * 1024; idx += gridDim.x * 512) { const int n = idx >> 10, k = idx & 1023;
        const float v = n < 4 ? rg[k * 4 + n] : n < 36 ? re[k * 32 + n - 4] : 0.f; W[SW_RT + idx] = f2bf(v); }
}
__device__ __forceinline__ void phase_cvt_experts(unsigned char* shm, LAS unsigned char* lds, int l, bf16_t* Wgu, bf16_t* Wdn) {
    const float* wg = INP(39) + (size_t)l * NEXP * D * FEXP; const float* wu = INP(40) + (size_t)l * NEXP * D * FEXP; const float* wd = INP(41) + (size_t)l * NEXP * FEXP * D;
    for (int t = blockIdx.x; t < NEXP * 96; t += gridDim.x) {
        const int e = t / 96, q = t % 96;
        if (q < 32) { const int tk = q >> 1, tn = q & 1;
            cvt_tile4<1>(shm, wg + (size_t)e * D * FEXP, FEXP, tk * 64, tn * 256, Wgu + (size_t)e * 1024 * 1024, 1024, tk * 64, 0, 1 << 30); }
        else if (q < 64) { const int qq = q - 32, tk = qq >> 1, tn = qq & 1;
            cvt_tile4<1>(shm, wu + (size_t)e * D * FEXP, FEXP, tk * 64, tn * 256, Wgu + (size_t)e * 1024 * 1024 + 4 * 1024, 1024, tk * 64, 0, 1 << 30); }
        else { const int qq = q - 64, tk = qq >> 2, tn = qq & 3;
            cvt_tile4<0>(shm, wd + (size_t)e * FEXP * D, D, tk * 64, tn * 256, Wdn + (size_t)e * 1024 * 512, 512, tk * 64, 0, 0); }
    }
}
__device__ __forceinline__ void phase_rope(float* rope) {
    const int idx = blockIdx.x * 512 + opaque_tid();
    if (idx < 1024) { const int pos = idx >> 4, i = idx & 15;
        const double base[4] = {1.0, 0.5623413251903491, 0.31622776601683794, 0.17782794100389228};
        double inv = (i & 3) == 0 ? base[0] : (i & 3) == 1 ? base[1] : (i & 3) == 2 ? base[2] : base[3];
        inv *= (i >> 2) == 0 ? 1.0 : (i >> 2) == 1 ? 0.1 : (i >> 2) == 2 ? 0.01 : 0.001;
        const double ang = (double)((float)pos * (float)inv); double s, c; sincos_d(ang, s, c);
        rope[idx * 2] = (float)c; rope[idx * 2 + 1] = (float)s; }
}

__device__ __forceinline__ void phase_norm(const float* src_lat, const float* src_ctx, int nrows, const float* gamma, const float* modl, int sh_off, int sc_off, bf16_t* hdst,
                                           bool comb, const float* modprev, const int* pos, const bf16_t* oslot, float* wb_lat, float* wb_ctx) {
    const int tid_ = opaque_tid(), lane = tid_ & 63, wid = tid_ >> 6;
    const int nwave = gridDim.x * 8, per = (nrows + nwave - 1) / nwave, r0 = (blockIdx.x * 8 + wid) * per, r1 = min(nrows, r0 + per);
    int row = r0;
    f32x4 v[4]; int p0 = 0, p1 = 0;
#define PN_LOAD(r_, vv, q0, q1) do { const bool lat_ = (r_) < NLAT; const float* sp_ = lat_ ? src_lat + (size_t)(r_) * D : src_ctx + (size_t)((r_) - NLAT) * D; \
        _Pragma("unroll") for (int q = 0; q < 4; ++q) vv[q] = *(const f32x4*)(sp_ + q * 256 + lane * 4); \
        if (comb) { q0 = pos[(r_) * 2]; q1 = pos[(r_) * 2 + 1]; } } while (0)
    if (row < r1) PN_LOAD(row, v, p0, p1);
    int mrc = -1;
    f32x4 gmv[4], scv[4], shv[4], g2v[4];
#pragma unroll
    for (int q = 0; q < 4; ++q) { gmv[q] = scv[q] = shv[q] = g2v[q] = (f32x4){0.f, 0.f, 0.f, 0.f}; if (hdst) gmv[q] = *(const f32x4*)(gamma + q * 256 + lane * 4); }
    while (row < r1) {
        const int nrow = row + 1;
        f32x4 vn[4]; int pn0 = 0, pn1 = 0;
        u32x2 o0[4], o1[4];
        const bool lat = row < NLAT; const int mr = lat ? (row >> 11) : 32;
        if (comb) {
#pragma unroll
            for (int q = 0; q < 4; ++q) { const int c = q * 256 + lane * 4; o0[q] = *(const u32x2*)(oslot + (size_t)p0 * D + c); o1[q] = *(const u32x2*)(oslot + (size_t)p1 * D + c); }
        }
        if (nrow < r1) PN_LOAD(nrow, vn, pn0, pn1);
        if (mr != mrc) { mrc = mr;
#pragma unroll
            for (int q = 0; q < 4; ++q) { const int c = q * 256 + lane * 4;
                if (hdst) { scv[q] = *(const f32x4*)(modl + (size_t)mr * MODW + sc_off + c); shv[q] = *(const f32x4*)(modl + (size_t)mr * MODW + sh_off + c); }
                if (comb) g2v[q] = *(const f32x4*)(modprev + (size_t)mr * MODW + 5 * D + c); } }
        if (comb) {
#pragma unroll
            for (int q = 0; q < 4; ++q) { const f32x4 g2 = g2v[q];
                v[q][0] += g2[0] * (bflo(o0[q][0]) + bflo(o1[q][0])); v[q][1] += g2[1] * (bfhi(o0[q][0]) + bfhi(o1[q][0]));
                v[q][2] += g2[2] * (bflo(o0[q][1]) + bflo(o1[q][1])); v[q][3] += g2[3] * (bfhi(o0[q][1]) + bfhi(o1[q][1])); }
            if (wb_lat) { float* wp = lat ? wb_lat + (size_t)row * D : wb_ctx + (size_t)(row - NLAT) * D;
#pragma unroll
                for (int q = 0; q < 4; ++q) *(f32x4*)(wp + q * 256 + lane * 4) = v[q]; }
        }
        if (hdst) {
            float ss = 0.f;
#pragma unroll
            for (int q = 0; q < 4; ++q) ss += v[q][0] * v[q][0] + v[q][1] * v[q][1] + v[q][2] * v[q][2] + v[q][3] * v[q][3];
            ss = wave_sum(ss);
            const float rs = rsqrtf(ss * (1.0f / D) + EPS);
#pragma unroll
            for (int q = 0; q < 4; ++q) { const int c = q * 256 + lane * 4;
                const f32x4 gm = gmv[q], sc = scv[q], sh = shv[q];
                f32x4 y;
#pragma unroll
                for (int e = 0; e < 4; ++e) y[e] = v[q][e] * rs * gm[e] * (1.0f + sc[e]) + sh[e];
                *(u32x2*)(hdst + (size_t)row * D + c) = (u32x2){cvt_pk_bf16(y[0], y[1]), cvt_pk_bf16(y[2], y[3])}; }
        }
#pragma unroll
        for (int q = 0; q < 4; ++q) v[q] = vn[q];
        p0 = pn0; p1 = pn1; row = nrow;
    }
#undef PN_LOAD
}

__device__ __forceinline__ void phase_prep(unsigned char* shm, bf16_t* qkv, bf16_t* vt, const bf16_t* urw, bf16_t* streams, bf16_t* alora,
                                           const float* q_gain, const float* k_gain, const float* rope, const float* convw, const float* k_k) {
    const int tid = opaque_tid(), lane = tid & 63, wid = tid >> 6;
    {
        bf16_t* tile = (bf16_t*)shm;
        for (int u = blockIdx.x; u < NB * 36; u += gridDim.x) {
            const int b = u / 36, kt = u % 36;
            { const int key = tid >> 3, piece = tid & 7; const int n = kt * 64 + key; const int row = n < CTX ? NLAT + b * CTX + n : b * SEQ + n - CTX;
#pragma unroll
              for (int p = 0; p < 4; ++p) { const u32x4 w = *(const u32x4*)(qkv + (size_t)row * 1024 + 768 + (piece + 8 * p) * 8); *(u32x4*)(tile + key * 264 + (piece + 8 * p) * 8) = w; } }
            __syncthreads();
            { const int ch = tid >> 1, half = tid & 1;
              bf16_t* dst = vt + ((size_t)(b * 4) * 64 + ch) * NKEY + kt * 64 + half * 32;
#pragma unroll
              for (int g = 0; g < 4; ++g) { unsigned w[4];
#pragma unroll
                  for (int jp = 0; jp < 4; ++jp) { unsigned lo, hi;
                      { const int s = g * 8 + jp * 2, sl = s & 15, ko = ((sl >> 2) & 1) * 8 + ((sl >> 3) & 1) * 4 + (sl & 3); lo = tile[(half * 32 + (s & 16) + ko) * 264 + ch]; }
                      { const int s = g * 8 + jp * 2 + 1, sl = s & 15, ko = ((sl >> 2) & 1) * 8 + ((sl >> 3) & 1) * 4 + (sl & 3); hi = tile[(half * 32 + (s & 16) + ko) * 264 + ch]; }
                      w[jp] = lo | (hi << 16); }
                  *(u32x4*)(dst + g * 8) = (u32x4){w[0], w[1], w[2], w[3]}; } }
            __syncthreads();
        }
    }
    {
        const int rstride = gridDim.x * 8, rfirst = blockIdx.x * 8 + wid;
        const int sub = lane & 7, d0 = sub * 8;
        float gq[2][8], rcs[8], rsn[8];
#pragma unroll
        for (int pass = 0; pass < 2; ++pass) { const int hh = (lane >> 3) + 8 * pass; const float* gp = (hh < 8 ? q_gain : k_gain) + d0; const f32x4 a = *(const f32x4*)gp, b4 = *(const f32x4*)(gp + 4);
#pragma unroll
            for (int i = 0; i < 4; ++i) { gq[pass][i] = a[i] * (hh < 8 ? 0.125f * LOG2E : 1.0f); gq[pass][4 + i] = b4[i] * (hh < 8 ? 0.125f * LOG2E : 1.0f); } }
        { const int t = rfirst & (SEQ - 1), prow = t >> 6, pcol = t & 63; const int ps = (sub < 4) ? prow : pcol; const int i0 = (sub & 1) * 8; const float* rp = rope + (ps * 16 + i0) * 2;
#pragma unroll
          for (int i = 0; i < 4; ++i) { const f32x4 v = *(const f32x4*)(rp + 4 * i); rcs[2 * i] = v[0]; rsn[2 * i] = v[1]; rcs[2 * i + 1] = v[2]; rsn[2 * i + 1] = v[3]; } }
        const bool first = (sub & 2) == 0;
        u32x4 wnx[3][2];
#pragma unroll
        for (int k = 0; k < 3; ++k) { const int r_ = rfirst + k * rstride; wnx[k][0] = wnx[k][1] = (u32x4){0u, 0u, 0u, 0u};
            if (r_ < NTOK) { wnx[k][0] = *(const u32x4*)(qkv + (size_t)r_ * 1024 + (lane >> 3) * 64 + d0); if ((lane >> 3) < 4) wnx[k][1] = *(const u32x4*)(qkv + (size_t)r_ * 1024 + ((lane >> 3) + 8) * 64 + d0); } }
        for (int row = rfirst; row < NTOK; row += rstride) {
            const bool lat = row < NLAT;
            const u32x4 wcur[2] = {wnx[0][0], wnx[0][1]};
#pragma unroll
            for (int k = 0; k < 2; ++k) { wnx[k][0] = wnx[k + 1][0]; wnx[k][1] = wnx[k + 1][1]; }
            { const int nrow = row + 3 * rstride;
              if (nrow < NTOK) { wnx[2][0] = *(const u32x4*)(qkv + (size_t)nrow * 1024 + (lane >> 3) * 64 + d0); if ((lane >> 3) < 4) wnx[2][1] = *(const u32x4*)(qkv + (size_t)nrow * 1024 + ((lane >> 3) + 8) * 64 + d0); } }
#pragma unroll
            for (int pass = 0; pass < 2; ++pass) {
                const int hh = (lane >> 3) + 8 * pass;
                if (hh < 12) {
                    bf16_t* p = qkv + (size_t)row * 1024 + hh * 64 + d0;
                    const u32x4 w = wcur[pass];
                    float x[8] = {bflo(w[0]), bfhi(w[0]), bflo(w[1]), bfhi(w[1]), bflo(w[2]), bfhi(w[2]), bflo(w[3]), bfhi(w[3])};
                    float ss = 0.f;
#pragma unroll
                    for (int i = 0; i < 8; ++i) ss += x[i] * x[i];
                    ss = sum8(ss);
                    const float rs = rsqrtf(ss * (1.0f / 64.0f) + EPS);
#pragma unroll
                    for (int i = 0; i < 8; ++i) x[i] = x[i] * rs * gq[pass][i];
                    if (lat) {
                        if ((rstride & (SEQ - 1)) != 0) {
                            const int t = row & (SEQ - 1), prow = t >> 6, pcol = t & 63; const int ps = (sub < 4) ? prow : pcol; const int i0 = (sub & 1) * 8; const float* rp = rope + (ps * 16 + i0) * 2;
#pragma unroll
                            for (int i = 0; i < 4; ++i) { const f32x4 v = *(const f32x4*)(rp + 4 * i); rcs[2 * i] = v[0]; rsn[2 * i] = v[1]; rcs[2 * i + 1] = v[2]; rsn[2 * i + 1] = v[3]; } }
                        float xo[8];
#pragma unroll
                        for (int i = 0; i < 8; ++i) xo[i] = dpp<0x4E>(x[i]);
#pragma unroll
                        for (int i = 0; i < 8; ++i) x[i] = first ? (x[i] * rcs[i] - xo[i] * rsn[i]) : (x[i] * rcs[i] + xo[i] * rsn[i]);
                    }
                    *(u32x4*)p = (u32x4){cvt_pk_bf16(x[0], x[1]), cvt_pk_bf16(x[2], x[3]), cvt_pk_bf16(x[4], x[5]), cvt_pk_bf16(x[6], x[7])};
                }
            }
        }
    }
#ifndef REP_PREPC
#define REP_PREPC 1
#endif
    for (int rpc_ = 0; rpc_ < REP_PREPC; ++rpc_)
    {
        const int nwave = gridDim.x * 8, per = (NTOK + nwave - 1) / nwave, r0 = (blockIdx.x * 8 + wid) * per, r1 = min(NTOK, r0 + per);
        const u32x4 z4 = (u32x4){0u, 0u, 0u, 0u};
        u32x4 wp[2] = {z4, z4}, wc[2] = {z4, z4}, wn[2] = {z4, z4}, w2[2] = {z4, z4}, w3[2] = {z4, z4};
        if (r0 < r1) {
#pragma unroll
            for (int q = 0; q < 2; ++q) { if (r0 > 0) wp[q] = *(const u32x4*)(urw + (size_t)(r0 - 1) * 1024 + q * 512 + lane * 8); wc[q] = *(const u32x4*)(urw + (size_t)r0 * 1024 + q * 512 + lane * 8);
                if (r0 + 1 < NTOK) wn[q] = *(const u32x4*)(urw + (size_t)(r0 + 1) * 1024 + q * 512 + lane * 8);
                if (r0 + 2 < NTOK) w2[q] = *(const u32x4*)(urw + (size_t)(r0 + 2) * 1024 + q * 512 + lane * 8); }
        }
        for (int row = r0; row < r1; ++row) {
            const bool lat = row < NLAT; const int t = lat ? (row & (SEQ - 1)) : ((row - NLAT) & (CTX - 1)); const int len = lat ? SEQ : CTX;
            const bool hasp = t > 0, hasn = t < len - 1;
            if (row + 3 < NTOK) {
#pragma unroll
                for (int q = 0; q < 2; ++q) w3[q] = *(const u32x4*)(urw + (size_t)(row + 3) * 1024 + q * 512 + lane * 8);
            }
            float kkn[8];
#pragma unroll
            for (int q = 0; q < 2; ++q) {
                const int ch = q * 512 + lane * 8;
                const u32x4 xp = hasp ? wp[q] : z4, xc = wc[q], xn = hasn ? wn[q] : z4;
                float z[8];
#pragma unroll
                for (int i = 0; i < 4; ++i) {
                    const int c0 = ch + 2 * i;
                    z[2 * i] = bflo(xp[i]) * convw[c0] + bflo(xc[i]) * convw[1024 + c0] + bflo(xn[i]) * convw[2048 + c0];
                    z[2 * i + 1] = bfhi(xp[i]) * convw[c0 + 1] + bfhi(xc[i]) * convw[1024 + c0 + 1] + bfhi(xn[i]) * convw[2048 + c0 + 1];
                }
                if (q == 0) {
                    const int sidx = lane < 32 ? 0 : 1; const int cc = ch - sidx * 256;
                    *(u32x4*)(streams + (size_t)sidx * NTOK * 256 + (size_t)row * 256 + cc) = (u32x4){cvt_pk_bf16(z[0], z[1]), cvt_pk_bf16(z[2], z[3]), cvt_pk_bf16(z[4], z[5]), cvt_pk_bf16(z[6], z[7])};
                    float ss = 0.f;
#pragma unroll
                    for (int i = 0; i < 8; ++i) { kkn[i] = z[i] * k_k[cc + i]; ss += kkn[i] * kkn[i]; }
                    ss = sum8(ss);
                    const float rn = rsqrtf(ss + 1e-12f);
                    if (lane >= 32) *(u32x4*)(streams + (size_t)3 * NTOK * 256 + (size_t)row * 256 + cc) =
                        (u32x4){cvt_pk_bf16(kkn[0] * rn, kkn[1] * rn), cvt_pk_bf16(kkn[2] * rn, kkn[3] * rn), cvt_pk_bf16(kkn[4] * rn, kkn[5] * rn), cvt_pk_bf16(kkn[6] * rn, kkn[7] * rn)};
                } else {
                    if (lane < 32) {
                        *(u32x4*)(streams + (size_t)2 * NTOK * 256 + (size_t)row * 256 + (ch - 512)) = (u32x4){cvt_pk_bf16(z[0], z[1]), cvt_pk_bf16(z[2], z[3]), cvt_pk_bf16(z[4], z[5]), cvt_pk_bf16(z[6], z[7])};
                    } else {
                        const int cc = ch - 768;
#pragma unroll
                        for (int i = 0; i < 8; ++i) { if (cc < 64) { const float e2 = __expf(-2.0f * fabsf(z[i])); const float th = (1.0f - e2) * __builtin_amdgcn_rcpf(1.0f + e2); z[i] = z[i] < 0.f ? -th : th; } else if (cc >= 128) z[i] = sigmoidf_(z[i]); }
                        *(u32x4*)(alora + (size_t)row * 256 + cc) = (u32x4){cvt_pk_bf16(z[0], z[1]), cvt_pk_bf16(z[2], z[3]), cvt_pk_bf16(z[4], z[5]), cvt_pk_bf16(z[6], z[7])};
                    }
                }
            }
#pragma unroll
            for (int q = 0; q < 2; ++q) { wp[q] = wc[q]; wc[q] = wn[q]; wn[q] = w2[q]; w2[q] = w3[q]; }
        }
    }
}

__device__ __forceinline__ void rwkv_chain(LAS unsigned char* lds, int b, int h, int d, const bf16_t* streams, const bf16_t* lora, const float* k_a, bf16_t* yout) {
    const int tid = opaque_tid(), lane = tid & 63, wv = tid >> 6;
    LAS float* ybuf = (LAS float*)(lds + 98304);
    const bf16_t* Rp = streams, *Kp = streams + (size_t)NTOK * 256, *Vp = streams + (size_t)2 * NTOK * 256, *KKp = streams + (size_t)3 * NTOK * 256;
    const bf16_t* Ep = lora + (size_t)d * NTOK * 256, *Ap = lora + (size_t)(2 + d) * NTOK * 256;
    const int st = tid >> 4, c4 = (tid & 15) * 4;
    const f32x4 ka4 = *(const f32x4*)(k_a + h * 64 + c4);
    u32x2 g0, g1, g2, g3, g4, g5;
#define RW_GLOAD(blk) do { const size_t off = (size_t)seq_row(b, d, (blk) * 32 + st) * 256 + h * 64 + c4; \
        g0 = *(const u32x2*)(Rp + off); g1 = *(const u32x2*)(Kp + off); g2 = *(const u32x2*)(Vp + off); g3 = *(const u32x2*)(KKp + off); g4 = *(const u32x2*)(Ep + off); g5 = *(const u32x2*)(Ap + off); } while (0)
#define RW_LSTORE(bufp) do { LAS float* _bp = (bufp) + st * 64 + c4; \
        const f32x4 r_ = (f32x4){bflo(g0[0]), bfhi(g0[0]), bflo(g0[1]), bfhi(g0[1])}, k_ = (f32x4){bflo(g1[0]), bfhi(g1[0]), bflo(g1[1]), bfhi(g1[1])}; \
        const f32x4 v_ = (f32x4){bflo(g2[0]), bfhi(g2[0]), bflo(g2[1]), bfhi(g2[1])}, kk_ = (f32x4){bflo(g3[0]), bfhi(g3[0]), bflo(g3[1]), bfhi(g3[1])}; \
        const f32x4 e_ = (f32x4){bflo(g4[0]), bfhi(g4[0]), bflo(g4[1]), bfhi(g4[1])}, a_ = (f32x4){bflo(g5[0]), bfhi(g5[0]), bflo(g5[1]), bfhi(g5[1])}; \
        f32x4 w_, kt_; _Pragma("unroll") for (int _e = 0; _e < 4; ++_e) { w_[_e] = __expf(-e_[_e]); kt_[_e] = k_[_e] * (1.0f + (a_[_e] - 1.0f) * ka4[_e]); } \
        *(LAS f32x4*)(_bp) = w_; *(LAS f32x4*)(_bp + 2048) = kk_ * a_; *(LAS f32x4*)(_bp + 4096) = kt_; *(LAS f32x4*)(_bp + 6144) = kk_; *(LAS f32x4*)(_bp + 8192) = r_; *(LAS f32x4*)(_bp + 10240) = v_; } while (0)
    float S[8];
#pragma unroll
    for (int j = 0; j < 8; ++j) S[j] = 0.f;
    const int c8 = lane & 7, irow = wv * 8 + (lane >> 3);
    RW_GLOAD(0); RW_LSTORE((LAS float*)lds);
    __syncthreads();
    for (int blk = 0; blk < NKEY / 32; ++blk) {
        LAS float* cur = (LAS float*)(lds + (blk & 1) * 49152);
        LAS float* nxt = (LAS float*)(lds + ((blk + 1) & 1) * 49152);
        if (blk + 1 < NKEY / 32) RW_GLOAD(blk + 1);
#pragma unroll 4
        for (int s = 0; s < 32; ++s) {
            LAS float* sp = cur + s * 64 + c8 * 8;
            const f32x4 wA = *(LAS f32x4*)(sp), wB = *(LAS f32x4*)(sp + 4);
            const f32x4 qA = *(LAS f32x4*)(sp + 2048), qB = *(LAS f32x4*)(sp + 2052);
            const f32x4 tA = *(LAS f32x4*)(sp + 4096), tB = *(LAS f32x4*)(sp + 4100);
            const f32x4 kA = *(LAS f32x4*)(sp + 6144), kB = *(LAS f32x4*)(sp + 6148);
            const f32x4 rA = *(LAS f32x4*)(sp + 8192), rB = *(LAS f32x4*)(sp + 8196);
            const float vi = cur[10240 + s * 64 + irow];
            float sa = S[0] * kA[0] + S[1] * kA[1] + S[2] * kA[2] + S[3] * kA[3] + S[4] * kB[0] + S[5] * kB[1] + S[6] * kB[2] + S[7] * kB[3];
            sa = sum8(sa);
#pragma unroll
            for (int j = 0; j < 4; ++j) { S[j] = S[j] * wA[j] + (vi * tA[j] - sa * qA[j]); S[4 + j] = S[4 + j] * wB[j] + (vi * tB[j] - sa * qB[j]); }
            float y = S[0] * rA[0] + S[1] * rA[1] + S[2] * rA[2] + S[3] * rA[3] + S[4] * rB[0] + S[5] * rB[1] + S[6] * rB[2] + S[7] * rB[3];
            y = sum8(y);
            if (c8 == 0) ybuf[s * 64 + irow] = y;
        }
        __syncthreads();
        { const f32x4 y4 = *(LAS f32x4*)(ybuf + st * 64 + c4);
          *(u32x2*)(yout + (size_t)seq_row(b, d, blk * 32 + st) * 256 + h * 64 + c4) = (u32x2){cvt_pk_bf16(y4[0], y4[1]), cvt_pk_bf16(y4[2], y4[3])}; }
        if (blk + 1 < NKEY / 32) RW_LSTORE(nxt);
        __syncthreads();
    }
#undef RW_GLOAD
#undef RW_LSTORE
}

typedef short bf16x4 __attribute__((ext_vector_type(4)));
constexpr int RC_SLOT = 16896, RC_QT = 0, RC_GT = 2560, RC_VT = 12800, RC_NB = 14848, RC_T = 15872;
constexpr int RC_GL = RC_T;
constexpr int RC_SST = 8 * RC_SLOT;
__device__ __forceinline__ float bfu(unsigned short v) { return __uint_as_float((unsigned)v << 16); }
__device__ __forceinline__ void wave_lds_sync() { __builtin_amdgcn_fence(__ATOMIC_RELEASE, "wavefront"); __builtin_amdgcn_wave_barrier(); __builtin_amdgcn_fence(__ATOMIC_ACQUIRE, "wavefront"); }
__device__ __forceinline__ f32x4 mfma16_noovl(bf16x4 a, bf16x4 b, f32x4 c) {
    f32x4 d; asm volatile("s_nop 4\n\tv_mfma_f32_16x16x16_bf16 %0, %1, %2, %3\n\ts_nop 7\n\ts_nop 7" : "=&v"(d) : "v"(a), "v"(b), "v"(c)); return d; }
__device__ __forceinline__ void mfma16x5(f32x4& d0, f32x4& d1, f32x4& d2, f32x4& d3, f32x4& d4, bf16x4 a0, bf16x4 b0, f32x4 c0, bf16x4 a1, bf16x4 b1, f32x4 c1, bf16x4 a2, bf16x4 b2, f32x4 c2,
                                         bf16x4 a3, bf16x4 b3, f32x4 c3, bf16x4 a4, bf16x4 b4, f32x4 c4) {
    asm volatile("s_nop 7\n\tv_mfma_f32_16x16x16_bf16 %0, %5, %6, %7\n\tv_mfma_f32_16x16x16_bf16 %1, %8, %9, %10\n\tv_mfma_f32_16x16x16_bf16 %2, %11, %12, %13\n\t"
                 "v_mfma_f32_16x16x16_bf16 %3, %14, %15, %16\n\tv_mfma_f32_16x16x16_bf16 %4, %17, %18, %19\n\ts_nop 7\n\ts_nop 7"
                 : "=&v"(d0), "=&v"(d1), "=&v"(d2), "=&v"(d3), "=&v"(d4)
                 : "v"(a0), "v"(b0), "v"(c0), "v"(a1), "v"(b1), "v"(c1), "v"(a2), "v"(b2), "v"(c2), "v"(a3), "v"(b3), "v"(c3), "v"(a4), "v"(b4), "v"(c4)); }
__device__ __forceinline__ void mfma16x4(f32x4& d0, f32x4& d1, f32x4& d2, f32x4& d3, bf16x4 a0, bf16x4 b0, f32x4 c0, bf16x4 a1, bf16x4 b1, f32x4 c1, bf16x4 a2, bf16x4 b2, f32x4 c2, bf16x4 a3, bf16x4 b3, f32x4 c3) {
    asm volatile("s_nop 7\n\tv_mfma_f32_16x16x16_bf16 %0, %4, %5, %6\n\tv_mfma_f32_16x16x16_bf16 %1, %7, %8, %9\n\tv_mfma_f32_16x16x16_bf16 %2, %10, %11, %12\n\t"
                 "v_mfma_f32_16x16x16_bf16 %3, %13, %14, %15\n\ts_nop 7\n\ts_nop 7"
                 : "=&v"(d0), "=&v"(d1), "=&v"(d2), "=&v"(d3)
                 : "v"(a0), "v"(b0), "v"(c0), "v"(a1), "v"(b1), "v"(c1), "v"(a2), "v"(b2), "v"(c2), "v"(a3), "v"(b3), "v"(c3)); }
__device__ __forceinline__ void mfma16x4z(f32x4& d0, f32x4& d1, f32x4& d2, f32x4& d3, bf16x4 a0, bf16x4 b0, bf16x4 a1, bf16x4 b1, bf16x4 a2, bf16x4 b2, bf16x4 a3, bf16x4 b3) {
    asm volatile("s_nop 7\n\tv_mfma_f32_16x16x16_bf16 %0, %4, %5, 0\n\tv_mfma_f32_16x16x16_bf16 %1, %6, %7, 0\n\tv_mfma_f32_16x16x16_bf16 %2, %8, %9, 0\n\t"
                 "v_mfma_f32_16x16x16_bf16 %3, %10, %11, 0\n\ts_nop 7\n\ts_nop 7"
                 : "=&v"(d0), "=&v"(d1), "=&v"(d2), "=&v"(d3)
                 : "v"(a0), "v"(b0), "v"(a1), "v"(b1), "v"(a2), "v"(b2), "v"(a3), "v"(b3)); }
__device__ __forceinline__ void rwkv_chain_chunked(LAS unsigned char* lds, int b, int h, int d, const bf16_t* streams, const bf16_t* lora, const float* k_a, bf16_t* yout) {
    const int tid = opaque_tid(), lane = tid & 63, wv = tid >> 6, t = lane & 15, kg = lane >> 4;
    const int wvs = __builtin_amdgcn_readfirstlane(wv);
    const bf16_t* Rp = streams, *Kp = streams + (size_t)NTOK * 256, *Vp = streams + (size_t)2 * NTOK * 256, *KKp = streams + (size_t)3 * NTOK * 256;
    const bf16_t* Ep = lora + (size_t)d * NTOK * 256, *Ap = lora + (size_t)(2 + d) * NTOK * 256;
    LAS unsigned char* sl = lds + wv * RC_SLOT;
    LAS unsigned char* sst = lds + (RC_SST + (wvs & 3) * 2304);
    if (wv < 4) {
#pragma unroll
        for (int bj = 0; bj < 4; ++bj)
#pragma unroll
            for (int i = 0; i < 4; ++i) *(LAS bf16_t*)(sst + (4 * kg + i) * 144 + (16 * bj + t) * 2) = 0;
    }
    u32x4 raw[6][2];
#define RC_RAWLOAD(g_) do { int ln_ = lane; asm volatile("" : "+v"(ln_)); const int tt_ = ln_ & 15; const size_t off_ = (size_t)(seq_base(b, d, ((g_) * 8 + wvs) * 16) + (d ? -tt_ : tt_)) * 256 + h * 64 + 8 * (ln_ >> 4); \
        _Pragma("unroll") for (int ks = 0; ks < 2; ++ks) { raw[0][ks] = *(const u32x4*)(Rp + off_ + 32 * ks); raw[1][ks] = *(const u32x4*)(Kp + off_ + 32 * ks); \
            raw[3][ks] = *(const u32x4*)(KKp + off_ + 32 * ks); raw[4][ks] = *(const u32x4*)(Ep + off_ + 32 * ks); raw[5][ks] = *(const u32x4*)(Ap + off_ + 32 * ks); } } while (0)
    RC_RAWLOAD(0);
    for (int g = 0; g < NKEY / 128; ++g) {
        {
            int lane_ = lane; asm volatile("" : "+v"(lane_));
            const int lane = lane_, t = lane & 15, kg = lane >> 4;
            u32x4 pA[2], pB[2], pK[2], pR[2], pL[2], pKL[2];
            f32x4 kav[2][2];
#pragma unroll
            for (int ks = 0; ks < 2; ++ks) { kav[ks][0] = *(const f32x4*)(k_a + h * 64 + 32 * ks + 8 * kg); kav[ks][1] = *(const f32x4*)(k_a + h * 64 + 32 * ks + 8 * kg + 4); }
            const bf16x4 fI = __builtin_bit_cast(bf16x4, (u32x2){(4 * kg == t ? 0x3F80u : 0u) | (4 * kg + 1 == t ? 0x3F800000u : 0u), (4 * kg + 2 == t ? 0x3F80u : 0u) | (4 * kg + 3 == t ? 0x3F800000u : 0u)});
            u32x4 rawv[2];
            { const size_t offv_ = (size_t)(seq_base(b, d, (g * 8 + wvs) * 16) + (d ? -t : t)) * 256 + h * 64 + 8 * kg; rawv[0] = *(const u32x4*)(Vp + offv_); rawv[1] = *(const u32x4*)(Vp + offv_ + 32); }
            LAS unsigned char* glw = sl + ((t == 15) ? RC_GL : RC_NB);
#pragma unroll
            for (int ks = 0; ks < 2; ++ks) {
                float xr[8], xk[8], xkk[8], xe[8], xa[8];
                unpack8(raw[0][ks], xr); unpack8(raw[1][ks], xk); unpack8(raw[3][ks], xkk); unpack8(raw[4][ks], xe); unpack8(raw[5][ks], xa);
                float vA[8], vB[8], vK[8], vL[8], vR[8], vKL[8];
#pragma unroll
                for (int j = 0; j < 8; ++j) {
                    float lg = -xe[j];
                    { float y; y = dpp<0x111>(lg); lg += y; y = dpp<0x112>(lg); lg += y; y = dpp<0x114>(lg); lg += y; y = dpp<0x118>(lg); lg += y; }
                    const float gt = __expf(lg), gi = __expf(-lg);
                    const float gtL = __shfl(gt, (lane & 48) | 15), gsh = dpp<0x111>(gt);
                    const float gp = (t == 0) ? 1.0f : gsh, gl = gtL * gi;
                    const float kka = xkk[j] * xa[j], kt = xk[j] * (1.0f + (xa[j] - 1.0f) * kav[ks][j >> 2][j & 3]);
                    vA[j] = -gp * xkk[j]; vB[j] = kka * gi; vK[j] = kt * gi; vR[j] = gt * xr[j];
                    vL[j] = kka * gl; vKL[j] = kt * gl;
                    *(LAS float*)(glw + (32 * ks + 8 * kg + j) * 4) = gt;
                }
                pA[ks] = pack8f(vA); pB[ks] = pack8f(vB); pK[ks] = pack8f(vK); pR[ks] = pack8f(vR); pL[ks] = pack8f(vL); pKL[ks] = pack8f(vKL);
            }
#define RC_F4R(p, beta) __builtin_bit_cast(bf16x4, (u32x2){p[(beta) >> 1][2 * ((beta) & 1)], p[(beta) >> 1][2 * ((beta) & 1) + 1]})
            f32x4 aT[4], lT[4];
            { f32x4 vT[4];
              mfma16x4z(vT[0], vT[1], vT[2], vT[3], RC_F4R(rawv, 0), fI, RC_F4R(rawv, 1), fI, RC_F4R(rawv, 2), fI, RC_F4R(rawv, 3), fI);
              mfma16x4z(aT[0], aT[1], aT[2], aT[3], RC_F4R(pA, 0), fI, RC_F4R(pA, 1), fI, RC_F4R(pA, 2), fI, RC_F4R(pA, 3), fI);
              mfma16x4z(lT[0], lT[1], lT[2], lT[3], RC_F4R(pL, 0), fI, RC_F4R(pL, 1), fI, RC_F4R(pL, 2), fI, RC_F4R(pL, 3), fI);
#pragma unroll
              for (int be = 0; be < 4; ++be) { const int nt = 32 * (be >> 1) + 8 * (t >> 2) + 4 * (be & 1) + (t & 3);
                  *(LAS u32x2*)(sl + RC_VT + nt * 32 + (4 * kg) * 2) = (u32x2){cvt_pk_bf16(vT[be][0], vT[be][1]), cvt_pk_bf16(vT[be][2], vT[be][3])}; } }
#undef RC_F4R
#define RC_F8(p) __builtin_bit_cast(bf16x8, p)
#define RC_F4(p, beta) __builtin_bit_cast(bf16x4, (u32x2){p[(beta) >> 1][2 * ((beta) & 1)], p[(beta) >> 1][2 * ((beta) & 1) + 1]})
#define RC_C4(x) __builtin_bit_cast(bf16x4, (u32x2){cvt_pk_bf16(x[0], x[1]), cvt_pk_bf16(x[2], x[3])})
#define RC_M16(a_, b_, c_) mfma16_noovl(a_, b_, c_)
            const f32x4 z4 = (f32x4){0.f, 0.f, 0.f, 0.f};
            f32x4 Nb = __builtin_amdgcn_mfma_f32_16x16x32_bf16(RC_F8(pB[0]), RC_F8(pA[0]), z4, 0, 0, 0); Nb = __builtin_amdgcn_mfma_f32_16x16x32_bf16(RC_F8(pB[1]), RC_F8(pA[1]), Nb, 0, 0, 0);
            f32x4 NkT = __builtin_amdgcn_mfma_f32_16x16x32_bf16(RC_F8(pA[0]), RC_F8(pK[0]), z4, 0, 0, 0); NkT = __builtin_amdgcn_mfma_f32_16x16x32_bf16(RC_F8(pA[1]), RC_F8(pK[1]), NkT, 0, 0, 0);
            f32x4 Mb = __builtin_amdgcn_mfma_f32_16x16x32_bf16(RC_F8(pB[0]), RC_F8(pR[0]), z4, 0, 0, 0); Mb = __builtin_amdgcn_mfma_f32_16x16x32_bf16(RC_F8(pB[1]), RC_F8(pR[1]), Mb, 0, 0, 0);
            f32x4 Mk = __builtin_amdgcn_mfma_f32_16x16x32_bf16(RC_F8(pK[0]), RC_F8(pR[0]), z4, 0, 0, 0); Mk = __builtin_amdgcn_mfma_f32_16x16x32_bf16(RC_F8(pK[1]), RC_F8(pR[1]), Mk, 0, 0, 0);
#pragma unroll
            for (int i = 0; i < 4; ++i) { const int s = 4 * kg + i;
                if (!(s < t)) Nb[i] = 0.f; if (!(t < s)) NkT[i] = 0.f; if (!(s <= t)) { Mb[i] = 0.f; Mk[i] = 0.f; }
                *(LAS float*)(sl + RC_NB + (s * 16 + t) * 4) = Nb[i]; }
            wave_lds_sync();
            float Tc[16];
#pragma unroll
            for (int rr = 15; rr >= 0; --rr) { float acc = (rr == t) ? 1.0f : 0.0f;
#pragma unroll
                for (int q = 3; q >= 0; --q) if (4 * q + 3 > rr) { const f32x4 nb = *(LAS f32x4*)(sl + RC_NB + (rr * 16 + 4 * q) * 4);
#pragma unroll
                    for (int e = 3; e >= 0; --e) if (4 * q + e > rr) acc += nb[e] * Tc[4 * q + e]; }
                Tc[rr] = acc; }
            f32x4 Tsel;
#pragma unroll
            for (int j = 0; j < 4; ++j) Tsel[j] = kg == 0 ? Tc[j] : kg == 1 ? Tc[4 + j] : kg == 2 ? Tc[8 + j] : Tc[12 + j];
            const bf16x4 fTT = RC_C4(Tsel);
            const bf16x4 fNk = RC_C4(NkT), fMb = RC_C4(Mb);
            bf16x4 fP[4], fLT[4], fW1;
            { bf16x4 fAT[4];
#pragma unroll
              for (int be = 0; be < 4; ++be) { fAT[be] = RC_C4(aT[be]); fLT[be] = RC_C4(lT[be]); }
              f32x4 W1T, pT[4];
              mfma16x5(W1T, pT[0], pT[1], pT[2], pT[3], fTT, fNk, z4, fTT, fAT[0], z4, fTT, fAT[1], z4, fTT, fAT[2], z4, fTT, fAT[3], z4);
              fW1 = RC_C4(W1T);
#pragma unroll
              for (int be = 0; be < 4; ++be) fP[be] = RC_C4(pT[be]); }
            float gln[4];
            { f32x4 Q2, q1[4], g2[4];
#define RC_U4(p, be) ((f32x4){bflo(p[(be) >> 1][2 * ((be) & 1)]), bfhi(p[(be) >> 1][2 * ((be) & 1)]), bflo(p[(be) >> 1][2 * ((be) & 1) + 1]), bfhi(p[(be) >> 1][2 * ((be) & 1) + 1])})
              mfma16x5(Q2, q1[0], q1[1], q1[2], q1[3], fW1, fMb, Mk, fP[0], fMb, RC_U4(pR, 0), fP[1], fMb, RC_U4(pR, 1), fP[2], fMb, RC_U4(pR, 2), fP[3], fMb, RC_U4(pR, 3));
              mfma16x4(g2[0], g2[1], g2[2], g2[3], fLT[0], fW1, RC_U4(pKL, 0), fLT[1], fW1, RC_U4(pKL, 1), fLT[2], fW1, RC_U4(pKL, 2), fLT[3], fW1, RC_U4(pKL, 3));
#undef RC_U4
              *(LAS u32x2*)(sl + RC_QT + t * 160 + (64 + 4 * kg) * 2) = (u32x2){cvt_pk_bf16(Q2[0], Q2[1]), cvt_pk_bf16(Q2[2], Q2[3])};
#pragma unroll
              for (int be = 0; be < 4; ++be) { const int ks = be >> 1, jh = be & 1, nt = 32 * ks + 8 * (t >> 2) + 4 * jh + (t & 3), n0 = 32 * ks + 8 * kg + 4 * jh;
                  gln[be] = *(LAS float*)(sl + RC_GL + nt * 4);
                  *(LAS u32x2*)(sl + RC_QT + t * 160 + n0 * 2) = (u32x2){cvt_pk_bf16(q1[be][0], q1[be][1]), cvt_pk_bf16(q1[be][2], q1[be][3])};
#pragma unroll
                  for (int i = 0; i < 4; ++i) *(LAS bf16_t*)(sl + RC_GT + (n0 + i) * 160 + (64 + t) * 2) = f2bf(g2[be][i]); } }
#pragma unroll
            for (int bj = 0; bj < 4; ++bj) { const int ntj = 32 * (bj >> 1) + 8 * (t >> 2) + 4 * (bj & 1) + (t & 3);
                f32x4 g1[4];
                mfma16x4z(g1[0], g1[1], g1[2], g1[3], fP[0], fLT[bj], fP[1], fLT[bj], fP[2], fLT[bj], fP[3], fLT[bj]);
#pragma unroll
                for (int bi = 0; bi < 4; ++bi) {
                    if (bi == bj) {
#pragma unroll
                        for (int i = 0; i < 4; ++i) g1[bi][i] += (4 * kg + i == t) ? gln[bj] : 0.f; }
                    *(LAS u32x2*)(sl + RC_GT + ntj * 160 + (32 * (bi >> 1) + 8 * kg + 4 * (bi & 1)) * 2) = (u32x2){cvt_pk_bf16(g1[bi][0], g1[bi][1]), cvt_pk_bf16(g1[bi][2], g1[bi][3])}; } }
#undef RC_F8
#undef RC_F4
#undef RC_C4
#undef RC_M16
        }
        __builtin_amdgcn_sched_barrier(0);
        if (g + 1 < NKEY / 128) RC_RAWLOAD(g + 1);
        __syncthreads();
        if (wv < 4) {
            int lane0_ = lane; asm volatile("" : "+v"(lane0_));
            bf16x8 Sa0 = *(LAS bf16x8*)(sst + (lane0_ & 15) * 144 + (8 * (lane0_ >> 4)) * 2), Sa1 = *(LAS bf16x8*)(sst + (lane0_ & 15) * 144 + (32 + 8 * (lane0_ >> 4)) * 2);
            {
                int lane_ = lane; asm volatile("" : "+v"(lane_));
                const int t = lane_ & 15, kg = lane_ >> 4;
                bf16x8 Bq[2][2], Bg[2][4][2]; bf16x4 Bq2[2], Bva[2], Bg2[2][4];
#define RA_LOADB(j8_, N) do { LAS unsigned char* cs_ = lds + (j8_) * RC_SLOT; \
                Bq[N][0] = *(LAS bf16x8*)(cs_ + RC_QT + t * 160 + (8 * kg) * 2); Bq[N][1] = *(LAS bf16x8*)(cs_ + RC_QT + t * 160 + (32 + 8 * kg) * 2); \
                Bq2[N] = *(LAS bf16x4*)(cs_ + RC_QT + t * 160 + (64 + 4 * kg) * 2); Bva[N] = *(LAS bf16x4*)(cs_ + RC_VT + (16 * wv + t) * 32 + (4 * kg) * 2); \
                _Pragma("unroll") for (int be = 0; be < 4; ++be) { LAS unsigned char* gp_ = cs_ + RC_GT + (32 * (be >> 1) + 8 * (t >> 2) + 4 * (be & 1) + (t & 3)) * 160; \
                    Bg[N][be][0] = *(LAS bf16x8*)(gp_ + (8 * kg) * 2); Bg[N][be][1] = *(LAS bf16x8*)(gp_ + (32 + 8 * kg) * 2); Bg2[N][be] = *(LAS bf16x4*)(gp_ + (64 + 4 * kg) * 2); } } while (0)
#define RA_STEP(j8_, C, N) do { \
                f32x4 Y = __builtin_amdgcn_mfma_f32_16x16x32_bf16(Sa0, Bq[C][0], (f32x4){0.f, 0.f, 0.f, 0.f}, 0, 0, 0); f32x4 Sn[4]; \
                _Pragma("unroll") for (int be = 0; be < 4; ++be) Sn[be] = __builtin_amdgcn_mfma_f32_16x16x32_bf16(Bg[C][be][0], Sa0, (f32x4){0.f, 0.f, 0.f, 0.f}, 0, 0, 0); \
                Y = __builtin_amdgcn_mfma_f32_16x16x32_bf16(Sa1, Bq[C][1], Y, 0, 0, 0); \
                _Pragma("unroll") for (int be = 0; be < 4; ++be) Sn[be] = __builtin_amdgcn_mfma_f32_16x16x32_bf16(Bg[C][be][1], Sa1, Sn[be], 0, 0, 0); \
                f32x4 Yf, Sf[4]; mfma16x5(Yf, Sf[0], Sf[1], Sf[2], Sf[3], Bva[C], Bq2[C], Y, Bg2[C][0], Bva[C], Sn[0], Bg2[C][1], Bva[C], Sn[1], Bg2[C][2], Bva[C], Sn[2], Bg2[C][3], Bva[C], Sn[3]); \
                RA_LOADB(((j8_) + 1) & 7, N); \
                *(u32x2*)(yout + (size_t)(seq_base(b, d, (g * 8 + (j8_)) * 16) + (d ? -t : t)) * 256 + h * 64 + 16 * wv + 4 * kg) = (u32x2){cvt_pk_bf16(Yf[0], Yf[1]), cvt_pk_bf16(Yf[2], Yf[3])}; \
                Sa0 = __builtin_bit_cast(bf16x8, (u32x4){cvt_pk_bf16(Sf[0][0], Sf[0][1]), cvt_pk_bf16(Sf[0][2], Sf[0][3]), cvt_pk_bf16(Sf[1][0], Sf[1][1]), cvt_pk_bf16(Sf[1][2], Sf[1][3])}); \
                Sa1 = __builtin_bit_cast(bf16x8, (u32x4){cvt_pk_bf16(Sf[2][0], Sf[2][1]), cvt_pk_bf16(Sf[2][2], Sf[2][3]), cvt_pk_bf16(Sf[3][0], Sf[3][1]), cvt_pk_bf16(Sf[3][2], Sf[3][3])}); } while (0)
                RA_LOADB(0, 0);
#pragma unroll 1
                for (int jj = 0; jj < 8; jj += 2) { RA_STEP(jj, 0, 1); RA_STEP(jj + 1, 1, 0); }
#undef RA_STEP
#undef RA_LOADB
            }
            { int lane1_ = lane; asm volatile("" : "+v"(lane1_));
              *(LAS bf16x8*)(sst + (lane1_ & 15) * 144 + (8 * (lane1_ >> 4)) * 2) = Sa0; *(LAS bf16x8*)(sst + (lane1_ & 15) * 144 + (32 + 8 * (lane1_ >> 4)) * 2) = Sa1; }
        }
        __syncthreads();
    }
}

__device__ __forceinline__ void s5_unit(LAS unsigned char* lds, int b, int gq, int l, const bf16_t* us5, bf16_t* ys5) {
    const int tid = opaque_tid(), lane = tid & 63, wv = tid >> 6;
    const int g = gq * 4 + (wv >> 1), d = wv & 1, pidx = (l * 2 + d) * 16 + g;
    const float* a_re = INP(10), *a_im = INP(11), *log_dt = INP(12), *b_re = INP(13), *b_im = INP(14), *c_re = INP(15), *c_im = INP(16);
    const double dt = exp((double)log_dt[pidx]);
    const int col = lane & 15, kg = lane >> 4;
    float ar, ai;
    { const double lr = a_re[pidx * 64 + lane], li = a_im[pidx * 64 + lane]; const double mag = exp(lr * dt); double s, c; sincos_d(li * dt, s, c); ar = (float)(mag * c); ai = (float)(mag * s); }
    bf16x8 Bf[8];
#pragma unroll
    for (int q = 0; q < 4; ++q) {
        const int n = 16 * q + col;
        const double lr = a_re[pidx * 64 + n], li = a_im[pidx * 64 + n]; const double mag = exp(lr * dt); double s, c; sincos_d(li * dt, s, c);
        const double abr = mag * c, abi = mag * s, den = lr * lr + li * li, nr = abr - 1.0;
        const float zr = (float)((nr * lr + abi * li) / den), zi = (float)((abi * lr - nr * li) / den);
        float bre[8], bim[8];
#pragma unroll
        for (int j = 0; j < 8; ++j) { const int c_ = (kg & 1) * 8 + j; const float x = b_re[((size_t)pidx * 64 + n) * 16 + c_], y = b_im[((size_t)pidx * 64 + n) * 16 + c_];
            bre[j] = kg < 2 ? zr * x - zi * y : 0.f; bim[j] = kg < 2 ? zr * y + zi * x : 0.f; }
        u32x4 w0 = (u32x4){cvt_pk_bf16(bre[0], bre[1]), cvt_pk_bf16(bre[2], bre[3]), cvt_pk_bf16(bre[4], bre[5]), cvt_pk_bf16(bre[6], bre[7])};
        u32x4 w1 = (u32x4){cvt_pk_bf16(bim[0], bim[1]), cvt_pk_bf16(bim[2], bim[3]), cvt_pk_bf16(bim[4], bim[5]), cvt_pk_bf16(bim[6], bim[7])};
        Bf[q] = __builtin_bit_cast(bf16x8, w0); Bf[4 + q] = __builtin_bit_cast(bf16x8, w1);
    }
    bf16x8 Cf[4];
#pragma unroll
    for (int ks = 0; ks < 4; ++ks) { float cv[8];
#pragma unroll
        for (int j = 0; j < 8; ++j) { const int comp = 32 * ks + 8 * kg + j, n = comp & 63; cv[j] = (comp < 64) ? c_re[((size_t)pidx * 16 + col) * 64 + n] : -c_im[((size_t)pidx * 16 + col) * 64 + n]; }
        u32x4 w = (u32x4){cvt_pk_bf16(cv[0], cv[1]), cvt_pk_bf16(cv[2], cv[3]), cvt_pk_bf16(cv[4], cv[5]), cvt_pk_bf16(cv[6], cv[7])}; Cf[ks] = __builtin_bit_cast(bf16x8, w); }
#ifdef DBG_NAN
    { unsigned* ctl_ = (unsigned*)(WSB() + WS_CTL) + (l ? 64 : 0); bool bad = !(fabsf(ar) < 1.5f) || !(fabsf(ai) < 1.5f);
      if (bad) ctl_[CW_DBG + 41] = 1u;
      bool badb = false;
#pragma unroll
      for (int q = 0; q < 8; ++q) { const u32x4 w = __builtin_bit_cast(u32x4, Bf[q]);
#pragma unroll
          for (int e = 0; e < 4; ++e) badb |= ((w[e] & 0x7f80u) == 0x7f80u) | ((w[e] & 0x7f800000u) == 0x7f800000u); }
      if (badb) ctl_[CW_DBG + 42] = 1u;
      if (!(dt > 0.0 && dt < 1.0)) ctl_[CW_DBG + 40] = 1u; }
#endif
    LAS float* BUs = (LAS float*)(lds + wv * 12544);
    LAS bf16_t* Hs = (LAS bf16_t*)(lds + wv * 12544 + 8192);
    float hre = 0.f, him = 0.f;
    const bf16x8 zero8 = (bf16x8){0, 0, 0, 0, 0, 0, 0, 0};
    bf16x8 uf0, uf1, uf2, uf3;
#define S5_ULOAD(blk) ((kg < 2) ? *(const bf16x8*)(us5 + (size_t)seq_row(b, d, (blk) * 16 + col) * 256 + g * 16 + 8 * kg) : zero8)
    uf0 = S5_ULOAD(0); uf1 = S5_ULOAD(1); uf2 = S5_ULOAD(2); uf3 = S5_ULOAD(3);
    bf16_t* yd = ys5 + (size_t)d * NTOK * 256 + g * 16 + col;
    unsigned* dbgp = (unsigned*)(WSB() + WS_CTL) + (l ? 64 : 0);
#define S5_BLOCK(blk, UF) do { \
        const bf16x8 ucur = UF; if ((blk) + 4 < NKEY / 16) UF = S5_ULOAD((blk) + 4); \
        _Pragma("unroll") for (int cb = 0; cb < 8; ++cb) { const f32x4 bu = __builtin_amdgcn_mfma_f32_16x16x32_bf16(ucur, Bf[cb], (f32x4){0.f, 0.f, 0.f, 0.f}, 0, 0, 0); \
            _Pragma("unroll") for (int i = 0; i < 4; ++i) { BUs[(4 * kg + i) * 128 + 16 * cb + col] = bu[i]; } } \
        __builtin_amdgcn_fence(__ATOMIC_RELEASE, "wavefront"); __builtin_amdgcn_wave_barrier(); __builtin_amdgcn_fence(__ATOMIC_ACQUIRE, "wavefront"); \
        { float xr_[16], xi_[16]; bf16_t hr_[16], hi_[16]; \
          _Pragma("unroll") for (int tt = 0; tt < 16; ++tt) { xr_[tt] = BUs[tt * 128 + lane]; xi_[tt] = BUs[tt * 128 + 64 + lane]; } \
          _Pragma("unroll") for (int tt = 0; tt < 16; ++tt) { const float nre = ar * hre - ai * him + xr_[tt], nim = ar * him + ai * hre + xi_[tt]; hre = nre; him = nim; hr_[tt] = f2bf(hre); hi_[tt] = f2bf(him); } \
          _Pragma("unroll") for (int tt = 0; tt < 16; ++tt) { Hs[tt * 136 + lane] = hr_[tt]; Hs[tt * 136 + 64 + lane] = hi_[tt]; } } \
        __builtin_amdgcn_fence(__ATOMIC_RELEASE, "wavefront"); __builtin_amdgcn_wave_barrier(); __builtin_amdgcn_fence(__ATOMIC_ACQUIRE, "wavefront"); \
        f32x4 yac = (f32x4){0.f, 0.f, 0.f, 0.f}; \
        _Pragma("unroll") for (int ks = 0; ks < 4; ++ks) { const bf16x8 hf = *(LAS bf16x8*)(Hs + col * 136 + 32 * ks + 8 * kg); yac = __builtin_amdgcn_mfma_f32_16x16x32_bf16(hf, Cf[ks], yac, 0, 0, 0); } \
        _Pragma("unroll") for (int i = 0; i < 4; ++i) { yd[(size_t)seq_row(b, d, (blk) * 16 + 4 * kg + i) * 256] = f2bf(yac[i]); } \
        __builtin_amdgcn_fence(__ATOMIC_RELEASE, "wavefront"); __builtin_amdgcn_wave_barrier(); __builtin_amdgcn_fence(__ATOMIC_ACQUIRE, "wavefront"); \
    } while (0)
    for (int b4 = 0; b4 < NKEY / 16; b4 += 4) { S5_BLOCK(b4, uf0); S5_BLOCK(b4 + 1, uf1); S5_BLOCK(b4 + 2, uf2); S5_BLOCK(b4 + 3, uf3); }
#undef S5_BLOCK
#undef S5_ULOAD
}

constexpr int ATT_RS = 144;
constexpr int ATT_TILE = 64 * ATT_RS;
__device__ __forceinline__ void attn_unit(LAS unsigned char* lds, bf16_t* qkv, const bf16_t* vt, int b, int kvh, int qrow0, int nkt, bf16_t* osep, float mbound) {
    const int tid = opaque_tid(), lane = tid & 63, wid = tid >> 6, q = lane & 31, h = lane >> 5;
    const int head = kvh * 2 + (wid >> 2);
    const size_t qrow = (size_t)(qrow0 + (wid & 3) * 32 + q);
    bf16x8 Qf[4];
#pragma unroll
    for (int kk = 0; kk < 4; ++kk) Qf[kk] = *(const bf16x8*)(qkv + qrow * 1024 + head * 64 + 16 * kk + 8 * h);
    const int lr = tid >> 3, lp = tid & 7;
    const bf16_t* vtp = vt + ((size_t)(b * 4 + kvh) * 64 + lr) * NKEY + lp * 8;
    const bf16_t* kbase = qkv + 512 + kvh * 64 + lp * 8;
#define ATT_KROW(n) ((n) < CTX ? (size_t)(NLAT + b * CTX + (n)) : (size_t)(b * SEQ + (n) - CTX))
#define ATT_GLOAD(kt_, kr, vr) do { const int n_ = (kt_) * 64 + lr; kr = *(const u32x4*)(kbase + ATT_KROW(n_) * 1024); vr = *(const u32x4*)(vtp + (kt_) * 64); } while (0)
#define ATT_LSTORE(kt_, kr, vr) do { LAS unsigned char* b_ = lds + ((kt_) % 3) * 2 * ATT_TILE; *(LAS u32x4*)(b_ + lr * ATT_RS + lp * 16) = kr; *(LAS u32x4*)(b_ + ATT_TILE + lr * ATT_RS + lp * 16) = vr; } while (0)
#define ATT_QK(kt_, SA, SB) do { LAS unsigned char* b_ = lds + ((kt_) % 3) * 2 * ATT_TILE; \
        _Pragma("unroll") for (int j = 0; j < 16; ++j) { SA[j] = 0.f; SB[j] = 0.f; } \
        _Pragma("unroll") for (int kk = 0; kk < 4; ++kk) { \
            const bf16x8 k0 = *(LAS bf16x8*)(b_ + q * ATT_RS + (16 * kk + 8 * h) * 2), k1 = *(LAS bf16x8*)(b_ + (32 + q) * ATT_RS + (16 * kk + 8 * h) * 2); \
            SA = __builtin_amdgcn_mfma_f32_32x32x16_bf16(k0, Qf[kk], SA, 0, 0, 0); SB = __builtin_amdgcn_mfma_f32_32x32x16_bf16(k1, Qf[kk], SB, 0, 0, 0); } } while (0)
    u32x4 kreg, vreg;
    ATT_GLOAD(0, kreg, vreg); ATT_LSTORE(0, kreg, vreg);
    if (1 < nkt) { ATT_GLOAD(1, kreg, vreg); ATT_LSTORE(1, kreg, vreg); }
    if (2 < nkt) ATT_GLOAD(2, kreg, vreg);
    __syncthreads();
    f32x16 O0, O1, S0, S1, T0, T1;
#pragma unroll
    for (int j = 0; j < 16; ++j) { O0[j] = 0.f; O1[j] = 0.f; }
    f32x16 Ls;
#pragma unroll
    for (int j = 0; j < 16; ++j) Ls[j] = 0.f;
    const bf16x8 ones8 = (bf16x8){0x3F80, 0x3F80, 0x3F80, 0x3F80, 0x3F80, 0x3F80, 0x3F80, 0x3F80};
    ATT_QK(0, S0, S1);
#define ATT_SOFTMAX_PV(kt_) \
        LAS unsigned char* buf = lds + ((kt_) % 3) * 2 * ATT_TILE; \
        _Pragma("unroll") for (int j = 0; j < 16; ++j) { S0[j] = __builtin_amdgcn_exp2f(S0[j] - mbound); S1[j] = __builtin_amdgcn_exp2f(S1[j] - mbound); } \
        bf16x8 pf[4]; \
        { u32x4 w; \
          w = (u32x4){cvt_pk_bf16(S0[0], S0[1]), cvt_pk_bf16(S0[2], S0[3]), cvt_pk_bf16(S0[4], S0[5]), cvt_pk_bf16(S0[6], S0[7])}; pf[0] = __builtin_bit_cast(bf16x8, w); \
          w = (u32x4){cvt_pk_bf16(S0[8], S0[9]), cvt_pk_bf16(S0[10], S0[11]), cvt_pk_bf16(S0[12], S0[13]), cvt_pk_bf16(S0[14], S0[15])}; pf[1] = __builtin_bit_cast(bf16x8, w); \
          w = (u32x4){cvt_pk_bf16(S1[0], S1[1]), cvt_pk_bf16(S1[2], S1[3]), cvt_pk_bf16(S1[4], S1[5]), cvt_pk_bf16(S1[6], S1[7])}; pf[2] = __builtin_bit_cast(bf16x8, w); \
          w = (u32x4){cvt_pk_bf16(S1[8], S1[9]), cvt_pk_bf16(S1[10], S1[11]), cvt_pk_bf16(S1[12], S1[13]), cvt_pk_bf16(S1[14], S1[15])}; pf[3] = __builtin_bit_cast(bf16x8, w); } \
        _Pragma("unroll") for (int g4 = 0; g4 < 4; ++g4) { \
            const bf16x8 v0 = *(LAS bf16x8*)(buf + ATT_TILE + q * ATT_RS + (16 * g4 + 8 * h) * 2), v1 = *(LAS bf16x8*)(buf + ATT_TILE + (32 + q) * ATT_RS + (16 * g4 + 8 * h) * 2); \
            O0 = __builtin_amdgcn_mfma_f32_32x32x16_bf16(v0, pf[g4], O0, 0, 0, 0); O1 = __builtin_amdgcn_mfma_f32_32x32x16_bf16(v1, pf[g4], O1, 0, 0, 0); \
            Ls = __builtin_amdgcn_mfma_f32_32x32x16_bf16(ones8, pf[g4], Ls, 0, 0, 0); }
    if (wid < 4) {
        for (int kt = 0; kt < nkt; ++kt) {
            if (kt + 1 < nkt) ATT_QK(kt + 1, T0, T1);
            ATT_SOFTMAX_PV(kt)
            if (kt + 2 < nkt) ATT_LSTORE(kt + 2, kreg, vreg);
            if (kt + 3 < nkt) ATT_GLOAD(kt + 3, kreg, vreg);
            __syncthreads();
#pragma unroll
            for (int j = 0; j < 16; ++j) { S0[j] = T0[j]; S1[j] = T1[j]; }
        }
    } else {
        for (int kt = 0; kt < nkt; ++kt) {
            { ATT_SOFTMAX_PV(kt) }
            __builtin_amdgcn_sched_barrier(0);
            if (kt + 1 < nkt) ATT_QK(kt + 1, S0, S1);
            if (kt + 2 < nkt) ATT_LSTORE(kt + 2, kreg, vreg);
            if (kt + 3 < nkt) ATT_GLOAD(kt + 3, kreg, vreg);
            __syncthreads();
        }
    }
#undef ATT_SOFTMAX_PV
#undef ATT_KROW
#undef ATT_GLOAD
#undef ATT_LSTORE
#undef ATT_QK
    const float inv = 1.0f / Ls[0];
    bf16_t* op = osep ? osep + qrow * 256 + (head & 3) * 64 + 4 * h : qkv + qrow * 1024 + head * 64 + 4 * h;
#pragma unroll
    for (int rg = 0; rg < 4; ++rg) {
        *(u32x2*)(op + 8 * rg) = (u32x2){cvt_pk_bf16(O0[4 * rg] * inv, O0[4 * rg + 1] * inv), cvt_pk_bf16(O0[4 * rg + 2] * inv, O0[4 * rg + 3] * inv)};
        *(u32x2*)(op + 32 + 8 * rg) = (u32x2){cvt_pk_bf16(O1[4 * rg] * inv, O1[4 * rg + 1] * inv), cvt_pk_bf16(O1[4 * rg + 2] * inv, O1[4 * rg + 3] * inv)};
    }
}

__device__ __forceinline__ void phase_mixers(LAS unsigned char* lds, int l, bool last, unsigned char* big, unsigned* qhead) {
    bf16_t* qkv = (bf16_t*)(big + BG_QKV); const bf16_t* vt = (const bf16_t*)(big + BG_VT);
    const bf16_t* streams = (const bf16_t*)(big + BG_STR); const bf16_t* lora = (const bf16_t*)(big + BG_URW);
    const bf16_t* us5 = (const bf16_t*)(big + BG_US5); bf16_t* ys5 = (bf16_t*)(big + BG_YS5); bf16_t* yrw = (bf16_t*)(big + BG_YRW);
#ifndef REP_RWKV
#define REP_RWKV 1
#endif
#ifndef REP_S5
#define REP_S5 1
#endif
#ifndef REP_ATT
#define REP_ATT 1
#endif
#ifndef DBG_ATT_ONLY
    const float* ka_l = INP(26) + l * 256;
    for (int rep = 0; rep < REP_RWKV; ++rep)
    for (int u = blockIdx.x; u < NB * 8; u += gridDim.x) { const int b = u >> 3, h = (u >> 1) & 3, d = u & 1;
#ifdef RWKV_DIRECT
        rwkv_chain(lds, b, h, d, streams, lora, INP(26) + l * 256, yrw + (size_t)d * NTOK * 256);
#else
        rwkv_chain_chunked(lds, b, h, d, streams, lora, ka_l, yrw + (size_t)d * NTOK * 256);
#endif
    }
    __syncthreads();
    for (int rep = 0; rep < REP_S5; ++rep)
    for (int u = blockIdx.x; u < NB * 4; u += gridDim.x) s5_unit(lds, u >> 2, u & 3, l, us5, ys5);
    __syncthreads();
#endif
    float mbound;
    { const float* qg = INP(8) + l * 64, *kg_ = INP(9) + l * 64; float mq = 0.f, mk = 0.f;
      for (int i = 0; i < 64; ++i) { mq = fmaxf(mq, fabsf(qg[i])); mk = fmaxf(mk, fabsf(kg_[i])); }
      mbound = __uint_as_float(__builtin_amdgcn_readfirstlane(__float_as_uint(8.0f * mq * mk * LOG2E * 1.001f))); }
#pragma unroll
    for (int rep = 0; rep < REP_ATT; ++rep) {
        bf16_t* osep = rep + 1 < REP_ATT ? (bf16_t*)(big + BG_OS5) : nullptr;
        const int c = blockIdx.x;
        if (gridDim.x == 256) {
            const int n_u = c < 128 ? 6 : 10, u0 = c < 128 ? c * 6 : 768 + (c - 128) * 10;
            for (int i = 0; i < n_u; ++i) { const int u = u0 + i, b = u >> 6, kvh = (u >> 4) & 3, qb = u & 15; attn_unit(lds, qkv, vt, b, kvh, b * SEQ + qb * 128, NKEY / 64, osep, mbound); __syncthreads(); }
            if (!last && c >= 128) for (int i = 0; i < 2; ++i) { const int v = (c - 128) * 2 + i, b = v >> 3, kvh = (v >> 1) & 3, cb = v & 1; attn_unit(lds, qkv, vt, b, kvh, NLAT + b * CTX + cb * 128, CTX / 64, osep, mbound); __syncthreads(); }
        } else {
            for (int u = c; u < 2048 + (last ? 0 : 256); u += gridDim.x) {
                if (u < 2048) { const int b = u >> 6, kvh = (u >> 4) & 3, qb = u & 15; attn_unit(lds, qkv, vt, b, kvh, b * SEQ + qb * 128, NKEY / 64, osep, mbound); }
                else { const int v = u - 2048, b = v >> 3, kvh = (v >> 1) & 3, cb = v & 1; attn_unit(lds, qkv, vt, b, kvh, NLAT + b * CTX + cb * 128, CTX / 64, osep, mbound); }
                __syncthreads();
            }
        }
    }
}

__device__ __forceinline__ float gelu_tanh(float x) { const float u = 0.7978845608028654f * (x + 0.044715f * x * x * x); const float e2 = __expf(-2.0f * fabsf(u)); float th = (1.0f - e2) * __builtin_amdgcn_rcpf(1.0f + e2); th = u < 0.f ? -th : th; return 0.5f * x * (1.0f + th); }
__device__ __forceinline__ void phase_finish(LAS unsigned char* lds, int l, int nrows, unsigned char* big) {
    const bf16_t* us5 = (const bf16_t*)(big + BG_US5); const bf16_t* ys5 = (const bf16_t*)(big + BG_YS5); bf16_t* yg = (bf16_t*)(big + BG_OS5);
    const float* dskip = INP(17) + l * 256;
    const int tid_ = opaque_tid();
    for (size_t idx = (size_t)blockIdx.x * 512 + tid_; idx < (size_t)nrows * 32; idx += (size_t)gridDim.x * 512) {
        const size_t off = idx * 8; const int c = (int)(off & 255);
        float s[8], y0[8], y1[8];
        unpack8(*(const u32x4*)(us5 + off), s); unpack8(*(const u32x4*)(ys5 + off), y0); unpack8(*(const u32x4*)(ys5 + (size_t)NTOK * 256 + off), y1);
#pragma unroll
        for (int i = 0; i < 8; ++i) s[i] = gelu_tanh(y0[i] + y1[i] + dskip[c + i] * s[i]);
        *(u32x4*)(yg + off) = pack8f(s);
    }
    const bf16_t* streams = (const bf16_t*)(big + BG_STR); const bf16_t* lora = (const bf16_t*)(big + BG_URW); const bf16_t* yrw = (const bf16_t*)(big + BG_YRW); bf16_t* orw = (bf16_t*)(big + BG_QKV) + 768;
    const float* k_a = INP(26) + l * 256, *r_k = INP(27) + l * 256, *ln_w = INP(28) + l * 256, *ln_b = INP(29) + l * 256;
    const int lane = tid_ & 63, wid = tid_ >> 6;
    for (int rp = blockIdx.x * 8 + wid; rp < nrows / 2; rp += gridDim.x * 8) {
        const size_t row = (size_t)rp * 2 + (lane >> 5); const int c = (lane & 31) * 8; const size_t off = row * 256 + c;
        float y0[8], y1[8], r[8], k[8], v[8], a0[8], a1[8], g[8];
        unpack8(*(const u32x4*)(yrw + off), y0); unpack8(*(const u32x4*)(yrw + (size_t)NTOK * 256 + off), y1);
        unpack8(*(const u32x4*)(streams + off), r); unpack8(*(const u32x4*)(streams + (size_t)NTOK * 256 + off), k); unpack8(*(const u32x4*)(streams + (size_t)2 * NTOK * 256 + off), v);
        unpack8(*(const u32x4*)(lora + (size_t)2 * NTOK * 256 + off), a0); unpack8(*(const u32x4*)(lora + (size_t)3 * NTOK * 256 + off), a1); unpack8(*(const u32x4*)(lora + (size_t)4 * NTOK * 256 + off), g);
        float sm = 0.f;
#pragma unroll
        for (int i = 0; i < 8; ++i) { y0[i] += y1[i]; sm += y0[i]; }
        const float mu = sum8(sm) * (1.0f / 64.0f);
        float sv = 0.f;
#pragma unroll
        for (int i = 0; i < 8; ++i) { y0[i] -= mu; sv += y0[i] * y0[i]; }
        const float rstd = rsqrtf(sum8(sv) * (1.0f / 64.0f) + GN_EPS);
        float bs = 0.f;
#pragma unroll
        for (int i = 0; i < 8; ++i) bs += r[i] * k[i] * (2.0f + (a0[i] + a1[i] - 2.0f) * k_a[c + i]) * r_k[c + i];
        bs = sum8(bs);
#pragma unroll
        for (int i = 0; i < 8; ++i) y0[i] = (y0[i] * rstd * ln_w[c + i] + ln_b[c + i] + bs * v[i]) * g[i];
        *(u32x4*)(orw + row * 1024 + c) = pack8f(y0);
    }
}

__device__ __forceinline__ void phase_route(LAS unsigned char* lds, const float* logits, const float* bg, const float* be, int ntok, int* tok_e, float* tok_w, int* wgcnt, int* stok) {
    LAS int* hist = (LAS int*)lds; const int tid_ = opaque_tid();
    for (int i = blockIdx.x * 512 + tid_; i < MAXBLK * 256; i += gridDim.x * 512) stok[i] = 0;
    if (tid_ < 32) hist[tid_] = 0;
    __syncthreads();
    const int chunk = (ntok + gridDim.x - 1) / gridDim.x, t0 = blockIdx.x * chunk, t1 = min(ntok, t0 + chunk);
    for (int tok = t0 + tid_; tok < t1; tok += 512) {
        const float* lp = logits + (size_t)tok * 64;
        const f32x4 gl = *(const f32x4*)lp + *(const f32x4*)bg;
        int gs = 0; float gm = gl[0];
        if (gl[1] > gm) { gm = gl[1]; gs = 1; } if (gl[2] > gm) { gm = gl[2]; gs = 2; } if (gl[3] > gm) { gm = gl[3]; gs = 3; }
        const float gden = __expf(gl[0] - gm) + __expf(gl[1] - gm) + __expf(gl[2] - gm) + __expf(gl[3] - gm);
        const float gw = 1.0f / gden;
        const f32x4 e0 = *(const f32x4*)(lp + 4 + gs * 8) + *(const f32x4*)(be + gs * 8), e1 = *(const f32x4*)(lp + 8 + gs * 8) + *(const f32x4*)(be + gs * 8 + 4);
        const float el[8] = {e0[0], e0[1], e0[2], e0[3], e1[0], e1[1], e1[2], e1[3]};
        int i1 = 0; float m1 = el[0];
#pragma unroll
        for (int i = 1; i < 8; ++i) if (el[i] > m1) { m1 = el[i]; i1 = i; }
        int i2 = -1; float m2 = -3.0e38f;
#pragma unroll
        for (int i = 0; i < 8; ++i) if (i != i1 && el[i] > m2) { m2 = el[i]; i2 = i; }
        const float t = __expf(m2 - m1), w1 = gw / (1.0f + t), w2 = gw * t / (1.0f + t);
        const int x1 = gs * 8 + i1, x2 = gs * 8 + i2;
        tok_e[tok * 2] = x1; tok_e[tok * 2 + 1] = x2; tok_w[tok * 2] = w1; tok_w[tok * 2 + 1] = w2;
        __hip_atomic_fetch_add(hist + x1, 1, __ATOMIC_RELAXED, __HIP_MEMORY_SCOPE_WORKGROUP); __hip_atomic_fetch_add(hist + x2, 1, __ATOMIC_RELAXED, __HIP_MEMORY_SCOPE_WORKGROUP);
    }
    __syncthreads();
    if (tid_ < 32) wgcnt[blockIdx.x * 32 + tid_] = hist[tid_];
    __syncthreads();
}
__device__ __forceinline__ void phase_scatter(LAS unsigned char* lds, const int* wgcnt, const int* tok_e, const float* tok_w, int* pos, float* sgate, int* blk_e,
                                              int* stok, int ntok) {
    LAS int* psum = (LAS int*)lds;
    LAS int* tsum = psum + 512;
    LAS int* basee = psum + 1024;
    LAS int* tote = psum + 1056;
    LAS int* cur0 = psum + 1088;
    LAS int* slots = psum + 1120;
    const int tid_ = opaque_tid(), lane = tid_ & 63, wid = tid_ >> 6;
    const int G = gridDim.x, chunk = (ntok + G - 1) / G, t0 = blockIdx.x * chunk, t1 = min(ntok, t0 + chunk), npair = max(0, t1 - t0) * 2;
    { const int e = tid_ & 31, part = tid_ >> 5, per = (G + 15) >> 4; int a = 0, t = 0;
      for (int w = part * per; w < part * per + per && w < G; ++w) { const int c = wgcnt[w * 32 + e]; t += c; a += (w < (int)blockIdx.x) ? c : 0; }
      psum[part * 32 + e] = a; tsum[part * 32 + e] = t; }
    __syncthreads();
    if (tid_ < 32) { int base = 0, tot = 0;
#pragma unroll
        for (int p = 0; p < 16; ++p) { base += psum[p * 32 + tid_]; tot += tsum[p * 32 + tid_]; }
        basee[tid_] = base; tote[tid_] = tot; }
    __syncthreads();
    if (tid_ == 0) { int bs = 0;
        for (int x = 0; x < NEXP; ++x) { const int nb = (tote[x] + 255) >> 8; cur0[x] = bs * 256 + basee[x]; if (blockIdx.x == 0) for (int i = 0; i < nb; ++i) blk_e[bs + i] = x; bs += nb; }
        if (blockIdx.x == 0) blk_e[MAXBLK] = bs; }
    __syncthreads();
    {
        int ev[10];
#pragma unroll
        for (int k = 0; k < 10; ++k) { const int i = k * 64 + lane; ev[k] = i < npair ? tok_e[t0 * 2 + i] : -1; }
        int run = 0;
        const int c0 = lane < 4 ? cur0[4 * wid + lane] : 0;
#pragma unroll
        for (int k = 0; k < 10; ++k) { if (k * 64 < npair) {
            const int i = k * 64 + lane, e = ev[k]; int sl = -1;
#pragma unroll
            for (int j = 0; j < 4; ++j) { const int x = 4 * wid + j; const unsigned long long m = __ballot(e == x); const int r = __builtin_amdgcn_readlane(run, j), b0 = __builtin_amdgcn_readlane(c0, j);
                if (e == x) sl = b0 + r + __popcll(m & ((1ull << lane) - 1ull));
                if (lane == j) run += __popcll(m); }
            if (sl >= 0) slots[i] = sl; } }
        for (int c = 640; c < npair; c += 64) {
            const int i = c + lane; const int e = i < npair ? tok_e[t0 * 2 + i] : -1; int sl = -1;
#pragma unroll
            for (int j = 0; j < 4; ++j) { const int x = 4 * wid + j; const unsigned long long m = __ballot(e == x); const int r = __builtin_amdgcn_readlane(run, j), b0 = __builtin_amdgcn_readlane(c0, j);
                if (e == x) sl = b0 + r + __popcll(m & ((1ull << lane) - 1ull));
                if (lane == j) run += __popcll(m); }
            if (sl >= 0) slots[i] = sl; }
    }
    __syncthreads();
    for (int i = tid_; i < npair; i += 512) { const int lane = 0;
        const int pi = t0 * 2 + i, slot = slots[i];
        if (lane == 0) { pos[pi] = slot; sgate[slot] = tok_w[pi]; stok[slot] = pi >> 1; }
    }
    __syncthreads();
}
#define WS_(T, off) ((T*)(WSB() + (off)))
#define BIG_(T, off) ((T*)(WSB() + WS_BIG + (off)))
#define MODL(l_) (WS_(float, WS_MOD) + (size_t)(l_) * 33 * MODW)
#define WSM(l_) (WS_(bf16_t, WS_W) + (size_t)(l_) * SW_LAYER)

#ifdef DBG_NAN
__device__ __forceinline__ void dbg_scan(unsigned* ctl, const void* p, size_t bytes, int code, bool isf32) {
    const u32x4* q = (const u32x4*)p; const size_t n = bytes / 16; bool bad = false;
    const int tid_ = opaque_tid();
    for (size_t i = (size_t)blockIdx.x * 512 + tid_; i < n; i += (size_t)gridDim.x * 512) { const u32x4 w = q[i];
#pragma unroll
        for (int e = 0; e < 4; ++e) { if (isf32) bad |= ((w[e] & 0x7f800000u) == 0x7f800000u); else bad |= ((w[e] & 0x7f80u) == 0x7f80u) | ((w[e] & 0x7f800000u) == 0x7f800000u); } }
    if (bad) ctl[CW_DBG + code] = 1u;
}
#define DBG_SCAN(ptr, bytes, code, isf32) dbg_scan(WS_(unsigned, WS_CTL), (ptr), (bytes), (code), (isf32))
#else
#define DBG_SCAN(ptr, bytes, code, isf32) do {} while (0)
#endif
template <int l> __device__ __forceinline__ void layer_body(unsigned char* shm, LAS unsigned char* lds, const XcdBarrier& bar) {
    using namespace pg8;
    const int G = gridDim.x, cidx = blockIdx.x;
    constexpr int ML = (l == DEPTH - 1) ? NLAT : NTOK;
#ifndef STOP_L0
#define STOP_L0 99
#endif
#define PHL(n) (PH_ON(n) && (l == 0 ? (n) <= STOP_L0 : (n) <= STOP_L1))
        if (PHL(3)) { if (l == 0) phase_norm(INP(0), INP(2), NTOK, INP(6), MODL(0), 0, D, WS_(bf16_t, WS_H), false, nullptr, nullptr, nullptr, nullptr, nullptr);
            else phase_norm(OUTP(), WS_(float, WS_XC), NTOK, INP(6) + l * D, MODL(l), 0, D, WS_(bf16_t, WS_H), true, MODL(l - 1), WS_(int, WS_META + MT_POS), BIG_(const bf16_t, BG_XS), OUTP(), WS_(float, WS_XC)); }
        xcd_barrier(bar);
        DBG_SCAN(WS_(bf16_t, WS_H), 4 * R36, 2 + 20 * l, false);
        if (PHL(4)) {
          if (l == DEPTH - 1) {
            { Gemm g{WS_(bf16_t, WS_H), WSM(l) + SW_IN, NLAT, NMIX, D, D}; StaticOrder S; S.init(NLAT, NMIX, G, cidx);
              EpiInproj E{BIG_(bf16_t, BG_QKV), BIG_(bf16_t, BG_US5), BIG_(bf16_t, BG_URW)}; gemm_phase(lds, g, S, E); }
            { Gemm g{WS_(bf16_t, WS_H) + (size_t)NLAT * D, WSM(l) + SW_IN + (size_t)512 * D, NCTX, NMIX - 512, D, D}; StaticOrder S; S.init(NCTX, NMIX - 512, G, cidx);
              EpiInproj E{BIG_(bf16_t, BG_QKV), BIG_(bf16_t, BG_US5), BIG_(bf16_t, BG_URW), NLAT / 256, 2}; gemm_phase(lds, g, S, E); }
          } else {
            Gemm g{WS_(bf16_t, WS_H), WSM(l) + SW_IN, NTOK, NMIX, D, D}; StaticOrder S; S.init(NTOK, NMIX, G, cidx);
            EpiInproj E{BIG_(bf16_t, BG_QKV), BIG_(bf16_t, BG_US5), BIG_(bf16_t, BG_URW)}; gemm_phase(lds, g, S, E); } }
        xcd_barrier(bar);
        DBG_SCAN(BIG_(bf16_t, BG_QKV), 4 * R36, 3 + 20 * l, false); DBG_SCAN(BIG_(bf16_t, BG_US5), 5 * R36, 3 + 20 * l, false);
        if (PHL(5)) phase_prep(shm, BIG_(bf16_t, BG_QKV), BIG_(bf16_t, BG_VT), BIG_(const bf16_t, BG_URW), BIG_(bf16_t, BG_STR), BIG_(bf16_t, BG_ORW),
                   INP(8) + l * 64, INP(9) + l * 64, WS_(float, WS_ROPE), INP(19) + (size_t)l * 3 * 1024, INP(25) + l * 256);
        xcd_barrier(bar);
        DBG_SCAN(BIG_(bf16_t, BG_QKV), 4 * R36, 4 + 20 * l, false); DBG_SCAN(BIG_(bf16_t, BG_VT), R36, 4 + 20 * l, false); DBG_SCAN(BIG_(bf16_t, BG_STR), 4 * R36, 4 + 20 * l, false); DBG_SCAN(BIG_(bf16_t, BG_ORW), R36, 4 + 20 * l, false);
        if (PHL(6)) { Gemm g{BIG_(const bf16_t, BG_ORW), WSM(l) + SW_LORA, NTOK, 1280, 256, 256}; StaticOrder S; S.init(NTOK, 1280, G, cidx);
          EpiLora E{BIG_(bf16_t, BG_URW), INP(20) + l * 512, INP(22) + l * 512}; gemm_phase(lds, g, S, E); }
        xcd_barrier(bar);
        DBG_SCAN(BIG_(bf16_t, BG_URW), 5 * R36, 5 + 20 * l, false);
        if (PHL(7)) phase_mixers(lds, l, l == DEPTH - 1, WSB() + WS_BIG, WS_(unsigned, WS_CTL) + CW_ATT + l * 64);
        xcd_barrier(bar);
        DBG_SCAN(BIG_(bf16_t, BG_QKV), 4 * R36, 6 + 20 * l, false); DBG_SCAN(BIG_(bf16_t, BG_YS5), 2 * R36, 7 + 20 * l, false); DBG_SCAN(BIG_(bf16_t, BG_YRW), 2 * R36, 8 + 20 * l, false);
        if (PHL(8)) phase_finish(lds, l, ML, WSB() + WS_BIG);
        xcd_barrier(bar);
        DBG_SCAN(BIG_(bf16_t, BG_US5), R36, 9 + 20 * l, false); DBG_SCAN(BIG_(bf16_t, BG_ORW), R36, 10 + 20 * l, false);
        if (PHL(9)) { Gemm g{BIG_(const bf16_t, BG_OS5), WSM(l) + SW_GLU, ML, 512, 256, 256}; StaticOrder S; S.init(ML, 512, G, cidx); EpiGlu E{BIG_(bf16_t, BG_QKV) + 512}; gemm_phase(lds, g, S, E); }
        if (PHL(10)) { Gemm g{WS_(bf16_t, WS_H), WSM(l) + SW_IN + (size_t)NMIX * D, ML, 3072, D, D}; StaticOrder S; S.init(ML, 3072, G, (cidx + (G >> 1)) % G);        EpiGates E{BIG_(bf16_t, BG_GATES)}; gemm_phase(lds, g, S, E); }
        xcd_barrier(bar);
        DBG_SCAN(BIG_(bf16_t, BG_OS5), R36, 11 + 20 * l, false); DBG_SCAN(BIG_(bf16_t, BG_GATES), 12 * R36, 12 + 20 * l, false);
        if (PHL(11)) { MergeArgs g{BIG_(const bf16_t, BG_QKV), WSM(l) + SW_PA, BIG_(const bf16_t, BG_GATES), BIG_(bf16_t, BG_MERGED), ML};
          StaticOrder S; S.init(ML, D, G, cidx); gemm_phase_merge(lds, g, S); }
        xcd_barrier(bar);
        DBG_SCAN(BIG_(bf16_t, BG_MERGED), 4 * R36, 13 + 20 * l, false);
        if (PHL(14)) { Gemm g{BIG_(const bf16_t, BG_MERGED), WSM(l) + SW_OUT, ML, D, D, D}; StaticOrder S; S.init(ML, D, G, cidx);
          EpiResid E{l == 0 ? INP(0) : OUTP(), l == 0 ? INP(2) : WS_(float, WS_XC), OUTP(), WS_(float, WS_XC), MODL(l) + 2 * D}; gemm_phase(lds, g, S, E); }
        xcd_barrier(bar);
        DBG_SCAN(OUTP(), (size_t)NLAT * D * 4, 14 + 20 * l, true); DBG_SCAN(WS_(float, WS_XC), (size_t)NCTX * D * 4, 14 + 20 * l, true);
        if (PHL(15)) phase_norm(OUTP(), WS_(float, WS_XC), ML, INP(34) + l * D, MODL(l), 3 * D, 4 * D, WS_(bf16_t, WS_H), false, nullptr, nullptr, nullptr, nullptr, nullptr);
        if (PHL(16)) phase_cvt_experts(shm, lds, l, BIG_(bf16_t, BG_WGU), BIG_(bf16_t, BG_WDN));
        xcd_barrier(bar);
        DBG_SCAN(WS_(bf16_t, WS_H), 4 * R36, 15 + 20 * l, false);
        if (PHL(17)) { Gemm g{WS_(bf16_t, WS_H), WSM(l) + SW_RT, ML, 256, D, D}; StaticOrder S; S.init(ML, 256, G, cidx); EpiLogits E{BIG_(float, BG_LOGIT)}; gemm_phase(lds, g, S, E); }
        xcd_barrier(bar);
        if (PHL(18)) phase_route(lds, BIG_(const float, BG_LOGIT), INP(36) + l * 4, INP(38) + l * 32, ML, WS_(int, WS_META + MT_TOKE), WS_(float, WS_META + MT_TOKW), WS_(int, WS_META + MT_WGCNT), WS_(int, WS_META + MT_STOK));
        xcd_barrier(bar);
        if (PHL(19)) phase_scatter(lds, WS_(const int, WS_META + MT_WGCNT), WS_(int, WS_META + MT_TOKE), WS_(float, WS_META + MT_TOKW), WS_(int, WS_META + MT_POS),
                                     WS_(float, WS_META + MT_SGATE), WS_(int, WS_META + MT_BLKE), WS_(int, WS_META + MT_STOK), ML);
        xcd_barrier(bar);
        if (PHL(20)) { const int* blk_e = WS_(int, WS_META + MT_BLKE); const int nblk = blk_e[MAXBLK]; Gemm g{WS_(const bf16_t, WS_H), BIG_(const bf16_t, BG_WGU), MAXBLK * 256, 1024, D, D}; MoeOrder S{nblk * 4, G, cidx, blk_e};
          EpiGU E{BIG_(bf16_t, BG_ACT)}; gemm_phase_gather(lds, g, WS_(const int, WS_META + MT_STOK), S, E); }
        xcd_barrier(bar);
        if (PHL(21)) { const int* blk_e = WS_(int, WS_META + MT_BLKE); const int nblk = blk_e[MAXBLK]; Gemm g{BIG_(const bf16_t, BG_ACT), BIG_(const bf16_t, BG_WDN), MAXBLK * 256, 1024, 512, 512}; MoeOrder S{nblk * 4, G, cidx, blk_e};
          EpiDown E{BIG_(bf16_t, BG_XS), WS_(float, WS_META + MT_SGATE)}; gemm_phase(lds, g, S, E); }
        xcd_barrier(bar);
    }

__global__ void __launch_bounds__(512, 2) fwd_kernel(Args a) {
    extern __shared__ __attribute__((aligned(16))) unsigned char shm[];
    LAS unsigned char* lds = (LAS unsigned char*)shm;
    if (threadIdx.x == 0) *(LAS u32x4*)(lds + LDS_BARW) = (u32x4){0u, 0u, 0u, 0u};
    if (threadIdx.x < 42) *(LAS unsigned long long*)(lds + LDS_PTR + threadIdx.x * 8) = (unsigned long long)a.in[threadIdx.x];
    if (threadIdx.x == 42) *(LAS unsigned long long*)(lds + LDS_PTR + 42 * 8) = (unsigned long long)a.out;
    if (threadIdx.x == 43) *(LAS unsigned long long*)(lds + LDS_PTR + 43 * 8) = (unsigned long long)a.ws;
    __syncthreads();
    XcdBarrier bar = xcd_barrier_post((unsigned*)(WSB() + WS_CTL) + CW_BAR, (volatile LAS unsigned*)(lds + LDS_BARW));
    const int G = gridDim.x, cidx = blockIdx.x;
    using namespace pg8;

    if (PH_ON(0)) phase_mod(shm, INP(1), INP(3), INP(4), INP(5), WS_(float, WS_MOD));
    if (PH_ON(1)) { phase_cvt_small(shm, lds, 0, WSM(0)); phase_cvt_small(shm, lds, 1, WSM(1)); }
    if (PH_ON(2)) phase_rope(WS_(float, WS_ROPE));
    xcd_barrier(bar);

    layer_body<0>(shm, lds, bar);
#ifndef DBG_L0ONLY
    layer_body<1>(shm, lds, bar);
#endif
#ifndef DBG_DUMP
    if (PH_ON(22)) phase_norm(OUTP(), WS_(float, WS_XC), NLAT, nullptr, MODL(0), 0, 0, nullptr, true, MODL(DEPTH - 1), WS_(int, WS_META + MT_POS), BIG_(const bf16_t, BG_XS), OUTP(), WS_(float, WS_XC));
#endif
#ifdef DBG_NAN
    xcd_barrier(bar);
    DBG_SCAN(WS_(float, WS_MOD), (size_t)2 * 33 * MODW * 4, 1, true);
    { unsigned* ctl = WS_(unsigned, WS_CTL); int code = 0;
      for (int c = 39; c >= 1; --c) if (ctl[CW_DBG + c]) code = c;
      for (int c = 59; c >= 40; --c) if (ctl[CW_DBG + c]) code = c;
      if (ctl[XB_TMO]) code = 60;
      float* o = OUTP();
      const int tid_ = opaque_tid();
      for (size_t i = (size_t)blockIdx.x * 512 + tid_; i < (size_t)NLAT * D; i += (size_t)gridDim.x * 512) { float v = o[i]; const bool nf = (__float_as_uint(v) & 0x7f800000u) == 0x7f800000u;
          if (code) v = 100.0f * code; else if (nf) v = 7000.0f; o[i] = v; } }
#endif
#ifdef DBG_DUMP
    xcd_barrier(bar);
    { const int tid_ = opaque_tid(); float* o = OUTP(); const bf16_t* bg = BIG_(const bf16_t, 0);
      for (size_t i = (size_t)blockIdx.x * 512 + tid_; i < (size_t)NLAT * D; i += (size_t)gridDim.x * 512) { float v = 0.f;
          { const bool sel = DUMP_SEL; v = sel ? (float)(bg[(size_t)DUMP_OFF / 2 + i] & 0xffu) : 0.f; }
          o[i] = v; } }
#endif
}

extern "C" void kernel_launch(void* const* d_in, const int* in_sizes, int n_in, void* d_out, int out_size, void* d_ws, size_t ws_size, hipStream_t stream) {
    static int grid = 0;
    if (grid == 0) {
        if (n_in != 42 || out_size != NLAT * D || ws_size < WS_END) { fprintf(stderr, "kernel_launch: unexpected shapes (n_in %d out %d ws %zu)\n", n_in, out_size, ws_size); grid = -1; return; }
        int dev = 0, cus = 0, per_cu = 0;
        if (hipGetDevice(&dev) != hipSuccess || hipDeviceGetAttribute(&cus, hipDeviceAttributeMultiprocessorCount, dev) != hipSuccess) { grid = -1; return; }
        if (hipFuncSetAttribute((const void*)fwd_kernel, hipFuncAttributeMaxDynamicSharedMemorySize, LDS_BYTES) != hipSuccess) { fprintf(stderr, "kernel_launch: hipFuncSetAttribute failed\n"); grid = -1; return; }
        if (hipOccupancyMaxActiveBlocksPerMultiprocessor(&per_cu, (const void*)fwd_kernel, 512, LDS_BYTES) != hipSuccess || per_cu < 1) { fprintf(stderr, "kernel_launch: occupancy query says %d\n", per_cu); grid = -1; return; }
        grid = cus;
    }
    if (grid < 0) return;
    (void)in_sizes;
#if defined(DBG_NAN) || defined(DBG_DUMP) || defined(WS_ZERO)
    (void)hipMemsetAsync((char*)d_ws, 0, WS_END, stream);
#else
    (void)hipMemsetAsync((char*)d_ws + WS_CTL, 0, CTL_BYTES, stream);
#endif
    Args a{};
    for (int i = 0; i < 42; ++i) a.in[i] = (const float*)d_in[i];
    a.out = (float*)d_out; a.ws = (unsigned char*)d_ws;
    hipLaunchKernelGGL(fwd_kernel, dim3(grid), dim3(512), LDS_BYTES, stream, a);
}
```
